# Optimizing an MI355X kernel written in HIP

```python
import math
import jax, jax.numpy as jnp
from jax import lax
import numpy as np

D_MODEL = 1024
BATCH = 8
SEQ = 4096
DEPTH = 2

N_HEADS_MLA = 8
MLA_QK_NOPE = 64
MLA_QK_ROPE = 32
MLA_V = 64
MLA_Q_RANK = 768
MLA_KV_RANK = 256
MLA_QK = MLA_QK_NOPE + MLA_QK_ROPE

N_HEADS_SB = 8
SB_HEAD = 64

N_HEADS_MOBA = 8
MOBA_HEAD = 64
MOBA_BLOCK = 256
MOBA_TOPK = 3
MOBA_Q_CHUNK = 32

Q_BLOCK = 128
ROPE_THETA = 500000.0
PARTIAL_ROPE_DIM = MOBA_HEAD // 4
D_FF = 4 * D_MODEL
N_BRANCH = 3
EPS = 1e-6
NEG_INF = -1e30

W_MLA = N_HEADS_MLA * MLA_V
W_SB = N_HEADS_SB * SB_HEAD
W_MOBA = N_HEADS_MOBA * MOBA_HEAD

IN_SPLITS = (MLA_Q_RANK, MLA_KV_RANK, MLA_QK_ROPE, 3 * W_SB, 3 * W_MOBA, N_BRANCH * D_MODEL)
D_IN = sum(IN_SPLITS)
SPLIT_POINTS = [int(v) for v in np.cumsum(IN_SPLITS)[:-1]]

kernel_name = "hybrid_mla_stickbreak_moba_adaln"


def rmsnorm(x, g):
    xf = x.astype(jnp.float32)
    y = xf * lax.rsqrt(jnp.mean(xf * xf, axis=-1, keepdims=True) + EPS)
    return y.astype(x.dtype) * g


def modulate(h, shift, scale):
    return h * (1.0 + scale[:, None, :]) + shift[:, None, :]


def rope_tables(positions, rot_dim, dtype):
    inv = ROPE_THETA ** (-jnp.arange(0, rot_dim, 2, dtype=jnp.float32) / rot_dim)
    ang = positions.astype(jnp.float32)[..., None] * inv
    return jnp.cos(ang)[:, None].astype(dtype), jnp.sin(ang)[:, None].astype(dtype)


def apply_rope(x, cos, sin):
    rd = 2 * cos.shape[-1]
    xr, xp = x[..., :rd], x[..., rd:]
    x1, x2 = xr[..., : rd // 2], xr[..., rd // 2:]
    rot = jnp.concatenate([x1 * cos - x2 * sin, x1 * sin + x2 * cos], axis=-1)
    return jnp.concatenate([rot, xp], axis=-1)


def to_heads(t, n_heads):
    b, s, w = t.shape
    return t.reshape(b, s, n_heads, w // n_heads).transpose(0, 2, 1, 3)


def from_heads(t):
    b, h, s, d = t.shape
    return t.transpose(0, 2, 1, 3).reshape(b, s, h * d)


def causal_softmax_attention(q, k, v, scale):
    b, h, s, dq = q.shape
    nq = s // Q_BLOCK
    qb = jnp.moveaxis(q.reshape(b, h, nq, Q_BLOCK, dq), 2, 0)
    kpos = jnp.arange(s)

    def body(args):
        qi, i = args
        sc = jnp.einsum('bhqd,bhkd->bhqk', qi, k).astype(jnp.float32) * scale
        qpos = i * Q_BLOCK + jnp.arange(Q_BLOCK)
        sc = jnp.where(kpos[None, :] <= qpos[:, None], sc, NEG_INF)
        p = jax.nn.softmax(sc, axis=-1).astype(v.dtype)
        return jnp.einsum('bhqk,bhkd->bhqd', p, v)

    o = lax.map(body, (qb, jnp.arange(nq)))
    return jnp.moveaxis(o, 0, 2).reshape(b, h, s, v.shape[-1])


def stick_breaking_attention(q, k, v):
    b, h, s, d = q.shape
    scale = 1.0 / math.sqrt(d)
    nq = s // Q_BLOCK
    qb = jnp.moveaxis(q.reshape(b, h, nq, Q_BLOCK, d), 2, 0)
    kpos = jnp.arange(s)

    def body(args):
        qi, i = args
        z = jnp.einsum('bhqd,bhkd->bhqk', qi, k).astype(jnp.float32) * scale
        qpos = i * Q_BLOCK + jnp.arange(Q_BLOCK)
        past = kpos[None, :] < qpos[:, None]
        log_beta = jax.nn.log_sigmoid(z)
        log_keep = jnp.where(past, jax.nn.log_sigmoid(-z), 0.0)
        later = lax.cumsum(log_keep, axis=3, reverse=True) - log_keep
        a = jnp.where(past, jnp.exp(log_beta + later), 0.0).astype(v.dtype)
        return jnp.einsum('bhqk,bhkd->bhqd', a, v)

    o = lax.map(body, (qb, jnp.arange(nq)))
    return jnp.moveaxis(o, 0, 2).reshape(b, h, s, d)


def moba_attention(q, k, v):
    b, h, s, d = q.shape
    scale = 1.0 / math.sqrt(d)
    nb = -(-s // MOBA_BLOCK)
    pad = nb * MOBA_BLOCK - s
    kb = jnp.pad(k, ((0, 0), (0, 0), (0, pad), (0, 0))).reshape(b, h, nb, MOBA_BLOCK, d)
    vb = jnp.pad(v, ((0, 0), (0, 0), (0, pad), (0, 0))).reshape(b, h, nb, MOBA_BLOCK, d)
    kmean = jnp.mean(kb.astype(jnp.float32), axis=3)

    cur = jnp.arange(s) // MOBA_BLOCK
    gate = jnp.einsum('bhsd,bhnd->bhsn', q.astype(jnp.float32), kmean)
    past_blk = jnp.arange(nb)[None, :] < cur[:, None]
    gate = jnp.where(past_blk, gate, NEG_INF)
    topk = min(MOBA_TOPK, nb)
    _, idx = lax.top_k(gate, topk)
    valid = jnp.arange(topk)[None, :] < cur[:, None]

    nc = s // MOBA_Q_CHUNK
    qc = jnp.moveaxis(q.reshape(b, h, nc, MOBA_Q_CHUNK, d), 2, 0)
    ic = jnp.moveaxis(idx.reshape(b, h, nc, MOBA_Q_CHUNK, topk), 2, 0)
    vc = valid.reshape(nc, MOBA_Q_CHUNK, topk)
    gather = jax.vmap(jax.vmap(lambda blocks, ids: blocks[ids]))

    def body(args):
        qi, ii, vi, ci = args
        kg = gather(kb, ii)
        vg = gather(vb, ii)
        qpos = ci * MOBA_Q_CHUNK + jnp.arange(MOBA_Q_CHUNK)
        s_sel = jnp.einsum('bhqd,bhqnjd->bhqnj', qi, kg).astype(jnp.float32) * scale
        s_sel = jnp.where(vi[:, :, None], s_sel, NEG_INF).reshape(b, h, MOBA_Q_CHUNK, topk * MOBA_BLOCK)
        ob = (ci * MOBA_Q_CHUNK) // MOBA_BLOCK
        k_own = lax.dynamic_index_in_dim(kb, ob, axis=2, keepdims=False)
        v_own = lax.dynamic_index_in_dim(vb, ob, axis=2, keepdims=False)
        s_own = jnp.einsum('bhqd,bhjd->bhqj', qi, k_own).astype(jnp.float32) * scale
        kpos = ob * MOBA_BLOCK + jnp.arange(MOBA_BLOCK)
        s_own = jnp.where(kpos[None, :] <= qpos[:, None], s_own, NEG_INF)
        p = jax.nn.softmax(jnp.concatenate([s_sel, s_own], axis=-1), axis=-1).astype(v.dtype)
        p_sel = p[..., : topk * MOBA_BLOCK].reshape(b, h, MOBA_Q_CHUNK, topk, MOBA_BLOCK)
        p_own = p[..., topk * MOBA_BLOCK:]
        return (jnp.einsum('bhqnj,bhqnjd->bhqd', p_sel, vg)
                + jnp.einsum('bhqj,bhjd->bhqd', p_own, v_own))

    o = lax.map(body, (qc, ic, vc, jnp.arange(nc)))
    return jnp.moveaxis(o, 0, 2).reshape(b, h, s, d)


def setup_inputs(seed: int = 0) -> dict:
    key = jax.random.key(seed)
    ks = jax.random.split(key, 24)
    f32 = jnp.float32

    def nrm(k, shape, fan_in):
        return jax.random.normal(k, shape, f32) * (fan_in ** -0.5)

    def gain(k, shape):
        return 1.0 + 0.02 * jax.random.normal(k, shape, f32)

    L = DEPTH
    return {
        "x": jax.random.normal(ks[0], (BATCH, SEQ, D_MODEL), f32),
        "c": jax.random.normal(ks[1], (BATCH, D_MODEL), f32),
        "positions": jnp.broadcast_to(jnp.arange(SEQ, dtype=jnp.int32)[None, :], (BATCH, SEQ)),
        "w_ada": nrm(ks[2], (L, D_MODEL, 6 * D_MODEL), D_MODEL),
        "b_ada": 0.02 * jax.random.normal(ks[3], (L, 6 * D_MODEL), f32),
        "norm1_g": gain(ks[4], (L, D_MODEL)),
        "norm2_g": gain(ks[5], (L, D_MODEL)),
        "w_in": nrm(ks[6], (L, D_MODEL, D_IN), D_MODEL),
        "q_norm_g": gain(ks[7], (L, MLA_Q_RANK)),
        "w_uq": nrm(ks[8], (L, MLA_Q_RANK, N_HEADS_MLA * MLA_QK), MLA_Q_RANK),
        "kv_norm_g": gain(ks[9], (L, MLA_KV_RANK)),
        "w_ukv": nrm(ks[10], (L, MLA_KV_RANK, N_HEADS_MLA * (MLA_QK_NOPE + MLA_V)), MLA_KV_RANK),
        "w_o_mla": nrm(ks[11], (L, W_MLA, D_MODEL), W_MLA),
        "w_o_sb": nrm(ks[12], (L, W_SB, D_MODEL), W_SB),
        "w_o_moba": nrm(ks[13], (L, W_MOBA, D_MODEL), W_MOBA),
        "w_out": nrm(ks[14], (L, D_MODEL, D_MODEL), D_MODEL),
        "w_ff1": nrm(ks[15], (L, D_MODEL, D_FF), D_MODEL),
        "w_ff2": nrm(ks[16], (L, D_FF, D_MODEL), D_FF),
        "final_norm_g": gain(ks[17], (D_MODEL,)),
    }


def reference(x, c, positions, w_ada, b_ada, norm1_g, norm2_g, w_in, q_norm_g, w_uq,
              kv_norm_g, w_ukv, w_o_mla, w_o_sb, w_o_moba, w_out, w_ff1, w_ff2, final_norm_g):
    b, s, _ = x.shape
    cos_mla, sin_mla = rope_tables(positions, MLA_QK_ROPE, x.dtype)
    cos_mb, sin_mb = rope_tables(positions, PARTIAL_ROPE_DIM, x.dtype)
    c_act = jax.nn.silu(c)
    mla_scale = 1.0 / math.sqrt(MLA_QK)

    for l in range(DEPTH):
        mod = c_act @ w_ada[l] + b_ada[l]
        shift1, scale1, gate1, shift2, scale2, gate2 = jnp.split(mod, 6, axis=-1)

        hdn = modulate(rmsnorm(x, norm1_g[l]), shift1, scale1)
        proj = hdn @ w_in[l]
        q_lat, c_kv, k_pe, sb_qkv, mb_qkv, gates = jnp.split(proj, SPLIT_POINTS, axis=-1)

        q = to_heads(rmsnorm(q_lat, q_norm_g[l]) @ w_uq[l], N_HEADS_MLA)
        q_nope, q_pe = q[..., :MLA_QK_NOPE], q[..., MLA_QK_NOPE:]
        kv = to_heads(rmsnorm(c_kv, kv_norm_g[l]) @ w_ukv[l], N_HEADS_MLA)
        k_nope, v_mla = kv[..., :MLA_QK_NOPE], kv[..., MLA_QK_NOPE:]
        q_pe = apply_rope(q_pe, cos_mla, sin_mla)
        k_pe = apply_rope(k_pe[:, None], cos_mla, sin_mla)
        q_mla = jnp.concatenate([q_nope, q_pe], axis=-1)
        k_mla = jnp.concatenate([k_nope, jnp.broadcast_to(k_pe, k_nope.shape[:3] + (MLA_QK_ROPE,))], axis=-1)
        o_mla = from_heads(causal_softmax_attention(q_mla, k_mla, v_mla, mla_scale))

        q_sb, k_sb, v_sb = [to_heads(t, N_HEADS_SB) for t in jnp.split(sb_qkv, 3, axis=-1)]
        o_sb = from_heads(stick_breaking_attention(q_sb, k_sb, v_sb))

        q_mb, k_mb, v_mb = [to_heads(t, N_HEADS_MOBA) for t in jnp.split(mb_qkv, 3, axis=-1)]
        q_mb = apply_rope(q_mb, cos_mb, sin_mb)
        k_mb = apply_rope(k_mb, cos_mb, sin_mb)
        o_mb = from_heads(moba_attention(q_mb, k_mb, v_mb))

        g_a, g_b, g_c = jnp.split(jax.nn.sigmoid(gates), N_BRANCH, axis=-1)
        merged = (g_a * (o_mla @ w_o_mla[l]) + g_b * (o_sb @ w_o_sb[l])
                  + g_c * (o_mb @ w_o_moba[l]))
        x = x + gate1[:, None, :] * (merged @ w_out[l])

        hdn = modulate(rmsnorm(x, norm2_g[l]), shift2, scale2)
        ff = jnp.square(jax.nn.relu(hdn @ w_ff1[l])) @ w_ff2[l]
        x = x + gate2[:, None, :] * ff

    return rmsnorm(x, final_norm_g)
```

```cpp
#include <hip/hip_runtime.h>
#include <hip/hip_cooperative_groups.h>
#include <cstdio>
#include <cstdint>
namespace cg = cooperative_groups;

#define LAS __attribute__((address_space(3)))
#define DI __device__ __forceinline__
typedef unsigned short bf16_t;
typedef short bf16x8 __attribute__((ext_vector_type(8)));
typedef short s16x4 __attribute__((ext_vector_type(4)));
typedef float f32x4 __attribute__((ext_vector_type(4)));
typedef float f32x2 __attribute__((ext_vector_type(2)));
typedef float f32x16 __attribute__((ext_vector_type(16)));
typedef unsigned u32x4 __attribute__((ext_vector_type(4)));
typedef unsigned u32x2 __attribute__((ext_vector_type(2)));
typedef __bf16 bf16x2_t __attribute__((ext_vector_type(2)));

constexpr int T = 32768, SEQ = 4096, NB = 8, DM = 1024, DFF = 4096, DEPTH = 2;
constexpr float EPS = 1e-6f;
constexpr float LOG2E = 1.4426950408889634f;
constexpr float C_MLA = 0.10206207261596577f * LOG2E;
constexpr float C_MB = 0.125f * LOG2E;
constexpr int NWIN = 7424;

constexpr size_t MiB = 1u << 20;
constexpr size_t WS_CTR = 0;
constexpr size_t WS_MOD = 1 * MiB;
constexpr size_t WS_SSQQ = 2 * MiB;
constexpr size_t WS_SSQKV = 2 * MiB + 256 * 1024;
constexpr size_t WS_SSQX = 2 * MiB + 512 * 1024;
constexpr size_t WS_KMEAN = 3 * MiB;
constexpr size_t WS_ROPEM = 4 * MiB;
constexpr size_t WS_ROPEB = 8 * MiB;
constexpr size_t WS_BIAS1 = 10 * MiB;
constexpr size_t WS_BIAS2 = 11 * MiB;
constexpr size_t WS_W = 16 * MiB;
constexpr size_t W_IN = WS_W, W_UQ = WS_W + 15 * MiB, W_UKV = WS_W + 16 * MiB + 512 * 1024, W_O = WS_W + 17 * MiB, W_OUT = WS_W + 20 * MiB, W_FF1 = WS_W + 22 * MiB, W_FF2 = WS_W + 30 * MiB;
constexpr size_t WS_HDN = 56 * MiB;
constexpr size_t WS_QLAT = 120 * MiB;
constexpr size_t WS_CKV = 168 * MiB;
constexpr size_t WS_OMLA = 120 * MiB;
constexpr size_t WS_KPE = 184 * MiB;
constexpr size_t WS_SB = 186 * MiB;
constexpr size_t WS_MB = 282 * MiB;
constexpr size_t WS_QMLA = 378 * MiB;
constexpr size_t WS_STASH = 378 * MiB;
constexpr size_t WS_KVMLA = 426 * MiB;
constexpr size_t WS_MERGED = 426 * MiB;
constexpr size_t WS_H = 186 * MiB;
constexpr size_t WS_SSQXP = 490 * MiB;
constexpr size_t WS_SSQQP = 498 * MiB;
constexpr size_t WS_SSQKVP = 500 * MiB;
constexpr size_t WS_END = 502 * MiB;

constexpr int LDS_BYTES = 147456;
constexpr int NTHREADS = 512;

DI int tid_opaque() { int t = threadIdx.x; asm volatile("" : "+v"(t)); return t; }
DI unsigned pk2(float lo, float hi) { f32x2 v = {lo, hi}; bf16x2_t b = __builtin_convertvector(v, bf16x2_t); return __builtin_bit_cast(unsigned, b); }
DI float bf_lo(unsigned u) { return __uint_as_float(u << 16); }
DI float bf_hi(unsigned u) { return __uint_as_float(u & 0xffff0000u); }
DI u32x2 pk4(f32x4 v) { u32x2 r; r.x = pk2(v[0], v[1]); r.y = pk2(v[2], v[3]); return r; }
DI float wave_sum(float v) {
#pragma unroll
    for (int o = 32; o >= 1; o >>= 1) v += __shfl_xor(v, o);
    return v;
}
DI float fast_exp2(float x) { return __builtin_amdgcn_exp2f(x); }
DI float fast_exp(float x) { return __builtin_amdgcn_exp2f(x * LOG2E); }
DI float fast_log(float x) { return __builtin_amdgcn_logf(x) * 0.6931471805599453f; }
DI float sigmoidf_(float x) { return __builtin_amdgcn_rcpf(1.f + fast_exp(-x)); }

DI float sum16(const float* p) { const f32x4 a = *(const f32x4*)p, b = *(const f32x4*)(p + 4), c = *(const f32x4*)(p + 8), d = *(const f32x4*)(p + 12); return (((a[0] + a[1]) + (a[2] + a[3])) + ((b[0] + b[1]) + (b[2] + b[3]))) + (((c[0] + c[1]) + (c[2] + c[3])) + ((d[0] + d[1]) + (d[2] + d[3]))); }
DI float sum12(const float* p) { const f32x4 a = *(const f32x4*)p, b = *(const f32x4*)(p + 4), c = *(const f32x4*)(p + 8); return (((a[0] + a[1]) + (a[2] + a[3])) + ((b[0] + b[1]) + (b[2] + b[3]))) + ((c[0] + c[1]) + (c[2] + c[3])); }
DI float sum4(const float* p) { const f32x4 a = *(const f32x4*)p; return (a[0] + a[1]) + (a[2] + a[3]); }

struct Params {
    const float* x; const float* c; const int* pos; const float* w_ada; const float* b_ada; const float* norm1_g; const float* norm2_g;
    const float* w_in; const float* q_norm_g; const float* w_uq; const float* kv_norm_g; const float* w_ukv;
    const float* w_o_mla; const float* w_o_sb; const float* w_o_moba; const float* w_out; const float* w_ff1; const float* w_ff2; const float* final_g;
    float* out; unsigned char* ws;
    int ph_lo, ph_hi;
};

typedef const Params __attribute__((address_space(4)))* PP;

namespace pg8 {
constexpr int BM = 256, BK = 64, HALF = 128, HTB = HALF * BK * 2, STAGE_BYTES = 8 * HTB, NXCD = 8, WGM = 8;
DI int lds_byte(int r, int c) { const int st = (r >> 4) * 2 + (c >> 5), rr = r & 15, cc = c & 31, ob = rr * 64 + cc * 2; return st * 1024 + (ob ^ (((ob >> 9) & 1) << 5)); }
DI int perm32(int rho) { const int n = rho >> 4, i = rho & 15; return 8 * (i >> 2) + 4 * n + (i & 3); }
DI void stage_rc(int b, int& R, int& C) { const int st = b / 1024, sb = b % 1024, swz = sb ^ (((sb >> 9) & 1) << 5); R = (st >> 1) * 16 + swz / 64; C = (st & 1) * 32 + (swz % 64) / 2; }

enum { K_QLAT = 0, K_CKV, K_KPE, K_SB, K_MB, K_UQ, K_UKV, K_GATE, K_BR0, K_BR1, K_BR2, K_OUT, K_FF1, K_FF2 };
enum { M_PROJ = 0, M_UP, M_MERGE, M_OUT, M_FF1, M_FF2 };

struct Unit { const char* A; const char* B; int lda, ldb; int nt, kind; int pm, pn; };

DI void tile_map(int L, int nM, int nN, int& pm, int& pn) {
    const int nwg = nM * nN; int wgid = L;
    { const int q = nwg / NXCD, r = nwg % NXCD, xcd = wgid % NXCD, off = wgid / NXCD; wgid = (xcd < r ? xcd * (q + 1) : r * (q + 1) + (xcd - r) * q) + off; }
    const int nig = WGM * nN, gid = wgid / nig, fm = gid * WGM, gsz = (nM - fm) < WGM ? (nM - fm) : WGM;
    pm = __builtin_amdgcn_readfirstlane(fm + ((wgid % nig) % gsz)); pn = __builtin_amdgcn_readfirstlane((wgid % nig) / gsz);
}

struct Sched {
    int mode, G, c; const char* ws;
    DI bool next(int i, Unit& u) const {
        const int nM = T / BM;
        if (mode == M_PROJ) {
            const long L = (long)i * G + c; if (L >= nM * 17) return false;
            tile_map((int)L, nM, 17, u.pm, u.pn);
            u.lda = 2048; u.ldb = 2048; u.nt = 16;
            u.A = ws + WS_HDN + (size_t)u.pm * BM * 2048; u.B = ws + W_IN + (size_t)u.pn * BM * 2048;
            u.kind = u.pn < 3 ? K_QLAT : (u.pn == 3 ? K_CKV : (u.pn == 4 ? K_KPE : (u.pn < 11 ? K_SB : K_MB)));
            return true;
        } else if (mode == M_UP) {
            bool isuq; long L;
            if (G == 256) {
                if (i == 0) { isuq = true; L = c; }
                else if (i == 1) { if (c < 128) { isuq = true; L = 256 + c; } else { isuq = false; L = c - 128; } }
                else if (i == 2) { isuq = false; L = 128 + c; }
                else if (i == 3 && c >= 128) { isuq = false; L = 384 + (c - 128); }
                else return false;
            } else { const long LL = (long)i * G + c; if (LL >= nM * 7) return false; isuq = LL < nM * 3; L = isuq ? LL : LL - nM * 3; }
            if (isuq) { tile_map((int)L, nM, 3, u.pm, u.pn); u.lda = 1536; u.ldb = 1536; u.nt = 12; u.kind = K_UQ;
                u.A = ws + WS_QLAT + (size_t)u.pm * BM * 1536; u.B = ws + W_UQ + (size_t)u.pn * BM * 1536; }
            else { tile_map((int)L, nM, 4, u.pm, u.pn); u.lda = 512; u.ldb = 512; u.nt = 4; u.kind = K_UKV;
                u.A = ws + WS_CKV + (size_t)u.pm * BM * 512; u.B = ws + W_UKV + (size_t)u.pn * BM * 512; }
            return true;
        } else if (mode == M_MERGE) {
            const int tl = i / 6, sub = i - tl * 6, br = sub >> 1;
            const long L = (long)tl * G + c; if (L >= nM * 4) return false;
            tile_map((int)L, nM, 4, u.pm, u.pn);
            if ((sub & 1) == 0) { u.lda = 2048; u.ldb = 2048; u.nt = 16; u.kind = K_GATE;
                u.A = ws + WS_HDN + (size_t)u.pm * BM * 2048; u.B = ws + W_IN + (size_t)(4352 + br * 1024 + u.pn * BM) * 2048; }
            else { u.ldb = 1024; u.nt = 8; u.kind = K_BR0 + br;
                u.lda = br == 0 ? 1024 : 3072;
                u.A = ws + (br == 0 ? WS_OMLA : (br == 1 ? WS_SB : WS_MB)) + (size_t)u.pm * BM * u.lda;
                u.B = ws + W_O + (size_t)(br * 1024 + u.pn * BM) * 1024; }
            return true;
        } else if (mode == M_OUT) {
            const long L = (long)i * G + c; if (L >= nM * 4) return false;
            tile_map((int)L, nM, 4, u.pm, u.pn); u.lda = 2048; u.ldb = 2048; u.nt = 16; u.kind = K_OUT;
            u.A = ws + WS_MERGED + (size_t)u.pm * BM * 2048; u.B = ws + W_OUT + (size_t)u.pn * BM * 2048; return true;
        } else if (mode == M_FF1) {
            const long L = (long)i * G + c; if (L >= nM * 16) return false;
            tile_map((int)L, nM, 16, u.pm, u.pn); u.lda = 2048; u.ldb = 2048; u.nt = 16; u.kind = K_FF1;
            u.A = ws + WS_HDN + (size_t)u.pm * BM * 2048; u.B = ws + W_FF1 + (size_t)u.pn * BM * 2048; return true;
        } else {
            const long L = (long)i * G + c; if (L >= nM * 4) return false;
            tile_map((int)L, nM, 4, u.pm, u.pn); u.lda = 8192; u.ldb = 8192; u.nt = 64; u.kind = K_FF2;
            u.A = ws + WS_H + (size_t)u.pm * BM * 8192; u.B = ws + W_FF2 + (size_t)u.pn * BM * 8192; return true;
        }
    }
};

struct Epi {
    PP pp; int l;
    template <int NS> DI void rowstat(float (&rs)[2][4], const float* parts, float inv_n, float mul, int rowbase_wave, LAS float* buf, int lane, int fr) const {
#pragma unroll
        for (int h = 0; h < 2; ++h) { const float* pp = parts + (size_t)(rowbase_wave + h * 128 + lane) * (NS == 4 ? 4 : 16);
            const float sm = NS == 16 ? sum16(pp) : (NS == 12 ? sum12(pp) : sum4(pp)); buf[h * 64 + lane] = __builtin_amdgcn_rsqf(sm * inv_n + EPS) * mul; }
#pragma unroll
        for (int ai = 0; ai < 2; ++ai)
#pragma unroll
            for (int m = 0; m < 4; ++m) rs[ai][m] = buf[ai * 64 + m * 16 + fr];
    }
    DI void operator()(const f32x4 (&acc)[2][2][4][2], const Unit& u, int wr, int wc, int fr, int fq, int tid, LAS unsigned char* lds) const {
        asm volatile("" : "+v"(fr), "+v"(fq), "+v"(tid));
        PP q = pp; asm volatile("" : "+s"(q));
        unsigned char* ws = q->ws; float* out = q->out; const float* xin = l == 0 ? q->x : q->out;
        const float* mod = (const float*)(ws + WS_MOD) + (size_t)l * 8 * 6144;
        float* ssqx = (float*)(ws + WS_SSQXP);
        const float* ssq1 = ssqx + (size_t)l * T * 16; float* ssq2 = ssqx + (size_t)3 * T * 16; float* ssqn = ssqx + (size_t)(l + 1) * T * 16;
        const float* bias1 = (const float*)(ws + WS_BIAS1) + (size_t)l * 8 * NWIN; const float* bias2 = (const float*)(ws + WS_BIAS2) + (size_t)l * 8 * 4096;
        const float* g2 = q->norm2_g + l * 1024; const float* g1n = q->norm1_g + ((l + 1) % DEPTH) * 1024; const float* modn = (const float*)(ws + WS_MOD) + (size_t)((l + 1) % DEPTH) * 8 * 6144;
        const int rbw = u.pm * BM + wr * 64, bidx = (u.pm * BM) >> 12;
#define EPI_CASE_BEGIN asm volatile("" : "+v"(fr), "+v"(fq), "+v"(tid)); const int row0 = u.pm * BM + wr * 64 + fr, lc0 = wc * 32 + fq * 8, lane = tid & 63; LAS float* rsbuf = (LAS float*)(lds + 131072) + (tid >> 6) * 128; float rs[2][4]; (void)row0; (void)lc0; (void)lane; (void)rsbuf; (void)rs;
#define PK8(v0, v1) ((u32x4){pk2((v0)[0], (v0)[1]), pk2((v0)[2], (v0)[3]), pk2((v1)[0], (v1)[1]), pk2((v1)[2], (v1)[3])})
        switch (u.kind) {
        case K_QLAT: case K_CKV: { EPI_CASE_BEGIN
            const bool isq = u.kind == K_QLAT;
            bf16_t* dst = (bf16_t*)(ws + (isq ? WS_QLAT : WS_CKV)); const int ld = isq ? 768 : 256; const int cb = isq ? u.pn * 256 : 0;
            float* ssq = (float*)(ws + (isq ? WS_SSQQP : WS_SSQKVP));
            rowstat<16>(rs, ssq1, 1.f / 1024.f, 1.f, rbw, rsbuf, lane, fr);
            f32x4 bv[2][2];
#pragma unroll
            for (int bj = 0; bj < 2; ++bj)
#pragma unroll
                for (int n = 0; n < 2; ++n) bv[bj][n] = *(const f32x4*)(bias1 + bidx * NWIN + u.pn * 256 + lc0 + bj * 128 + n * 4);
#pragma unroll
            for (int ai = 0; ai < 2; ++ai)
#pragma unroll
                for (int m = 0; m < 4; ++m) { const int row = row0 + ai * 128 + m * 16; float s = 0.f;
#pragma unroll
                    for (int bj = 0; bj < 2; ++bj) { const f32x4 v0 = acc[ai][bj][m][0] * rs[ai][m] + bv[bj][0], v1 = acc[ai][bj][m][1] * rs[ai][m] + bv[bj][1];
                        s += ((v0[0] * v0[0] + v0[1] * v0[1]) + (v0[2] * v0[2] + v0[3] * v0[3])) + ((v1[0] * v1[0] + v1[1] * v1[1]) + (v1[2] * v1[2] + v1[3] * v1[3]));
                        *(u32x4*)(dst + (size_t)row * ld + cb + lc0 + bj * 128) = PK8(v0, v1); }
                    s += __shfl_xor(s, 16); s += __shfl_xor(s, 32);
                    if (fq == 0) { if (isq) ssq[(size_t)row * 16 + u.pn * 4 + wc] = s; else ssq[(size_t)row * 4 + wc] = s; } }
        } break;
        case K_KPE: { EPI_CASE_BEGIN
            if (wc == 0) {
                bf16_t* dst = (bf16_t*)(ws + WS_KPE); const float* rt = (const float*)(ws + WS_ROPEM);
                rowstat<16>(rs, ssq1, 1.f / 1024.f, 1.f, rbw, rsbuf, lane, fr);
                const f32x4 b0 = *(const f32x4*)(bias1 + bidx * NWIN + 1024 + fq * 8), b1 = *(const f32x4*)(bias1 + bidx * NWIN + 1024 + fq * 8 + 4);
#pragma unroll
                for (int ai = 0; ai < 2; ++ai)
#pragma unroll
                    for (int m = 0; m < 4; ++m) { const int row = row0 + ai * 128 + m * 16;
                        const float* rr = rt + (size_t)row * 32 + (fq & 1) * 8;
                        const f32x4 cs0 = *(const f32x4*)rr, cs1 = *(const f32x4*)(rr + 4), sn0 = *(const f32x4*)(rr + 16), sn1 = *(const f32x4*)(rr + 20);
                        const f32x4 v0 = acc[ai][0][m][0] * rs[ai][m] + b0, v1 = acc[ai][0][m][1] * rs[ai][m] + b1; f32x4 p0, p1;
#pragma unroll
                        for (int e = 0; e < 4; ++e) { p0[e] = __shfl_xor(v0[e], 32); p1[e] = __shfl_xor(v1[e], 32); }
                        const f32x4 o0 = fq < 2 ? (v0 * cs0 - p0 * sn0) : (p0 * sn0 + v0 * cs0), o1 = fq < 2 ? (v1 * cs1 - p1 * sn1) : (p1 * sn1 + v1 * cs1);
                        *(u32x4*)(dst + (size_t)row * 32 + fq * 8) = PK8(o0, o1); }
            }
        } break;
        case K_SB: case K_MB: { EPI_CASE_BEGIN
            const bool ismb = u.kind == K_MB;
            const int t = u.pn - (ismb ? 11 : 5); bf16_t* dst = (bf16_t*)(ws + (ismb ? WS_MB : WS_SB)); const float sc = t < 2 ? (ismb ? C_MB : 0.125f) : 1.f; const float* rt = (const float*)(ws + WS_ROPEB);
            const bool rope = ismb && (t < 4) && ((wc & 1) == 0);
            rowstat<16>(rs, ssq1, 1.f / 1024.f, 1.f, rbw, rsbuf, lane, fr);
            f32x4 bv[2][2];
#pragma unroll
            for (int bj = 0; bj < 2; ++bj)
#pragma unroll
                for (int n = 0; n < 2; ++n) bv[bj][n] = *(const f32x4*)(bias1 + bidx * NWIN + u.pn * 256 + lc0 + bj * 128 + n * 4);
#pragma unroll
            for (int ai = 0; ai < 2; ++ai)
#pragma unroll
                for (int m = 0; m < 4; ++m) { const int row = row0 + ai * 128 + m * 16;
                    f32x4 cs0 = {1.f, 1.f, 1.f, 1.f}, cs1 = cs0, sn0 = {0.f, 0.f, 0.f, 0.f}, sn1 = sn0;
                    if (rope) { const float* rr = rt + (size_t)row * 16; cs0 = *(const f32x4*)rr; cs1 = *(const f32x4*)(rr + 4); sn0 = *(const f32x4*)(rr + 8); sn1 = *(const f32x4*)(rr + 12); }
#pragma unroll
                    for (int bj = 0; bj < 2; ++bj) { f32x4 v0 = acc[ai][bj][m][0] * rs[ai][m] + bv[bj][0], v1 = acc[ai][bj][m][1] * rs[ai][m] + bv[bj][1];
                        if (rope) { f32x4 p0, p1;
#pragma unroll
                            for (int e = 0; e < 4; ++e) { p0[e] = __shfl_xor(v0[e], 16); p1[e] = __shfl_xor(v1[e], 16); }
                            if (fq == 0) { v0 = v0 * cs0 - p0 * sn0; v1 = v1 * cs1 - p1 * sn1; } else if (fq == 1) { v0 = p0 * sn0 + v0 * cs0; v1 = p1 * sn1 + v1 * cs1; } }
                        v0 = v0 * sc; v1 = v1 * sc;
                        *(u32x4*)(dst + (size_t)row * 1536 + t * 256 + lc0 + bj * 128) = PK8(v0, v1); } }
        } break;
        case K_UQ: { EPI_CASE_BEGIN
            bf16_t* dst = (bf16_t*)(ws + WS_QMLA); const float* rt = (const float*)(ws + WS_ROPEM);
            rowstat<12>(rs, (const float*)(ws + WS_SSQQP), 1.f / 768.f, C_MLA, rbw, rsbuf, lane, fr);
#pragma unroll
            for (int ai = 0; ai < 2; ++ai)
#pragma unroll
                for (int m = 0; m < 4; ++m) { const int row = row0 + ai * 128 + m * 16;
                    const float* rr = rt + (size_t)row * 32 + (fq & 1) * 8;
                    const f32x4 cs0 = *(const f32x4*)rr, cs1 = *(const f32x4*)(rr + 4), sn0 = *(const f32x4*)(rr + 16), sn1 = *(const f32x4*)(rr + 20);
#pragma unroll
                    for (int bj = 0; bj < 2; ++bj) { const int gc = u.pn * 256 + bj * 128 + wc * 32; const bool pe = ((gc >> 5) % 3) == 2;
                        f32x4 v0 = acc[ai][bj][m][0] * rs[ai][m], v1 = acc[ai][bj][m][1] * rs[ai][m];
                        if (pe) { f32x4 p0, p1;
#pragma unroll
                            for (int e = 0; e < 4; ++e) { p0[e] = __shfl_xor(v0[e], 32); p1[e] = __shfl_xor(v1[e], 32); }
                            if (fq < 2) { v0 = v0 * cs0 - p0 * sn0; v1 = v1 * cs1 - p1 * sn1; } else { v0 = p0 * sn0 + v0 * cs0; v1 = p1 * sn1 + v1 * cs1; } }
                        *(u32x4*)(dst + (size_t)row * 768 + gc + fq * 8) = PK8(v0, v1); } }
        } break;
        case K_UKV: { EPI_CASE_BEGIN
            bf16_t* dst = (bf16_t*)(ws + WS_KVMLA);
            rowstat<4>(rs, (const float*)(ws + WS_SSQKVP), 1.f / 256.f, 1.f, rbw, rsbuf, lane, fr);
#pragma unroll
            for (int ai = 0; ai < 2; ++ai)
#pragma unroll
                for (int m = 0; m < 4; ++m) { const int row = row0 + ai * 128 + m * 16;
#pragma unroll
                    for (int bj = 0; bj < 2; ++bj) { const f32x4 v0 = acc[ai][bj][m][0] * rs[ai][m], v1 = acc[ai][bj][m][1] * rs[ai][m];
                        *(u32x4*)(dst + (size_t)row * 1024 + u.pn * 256 + lc0 + bj * 128) = PK8(v0, v1); } }
        } break;
        case K_GATE: { EPI_CASE_BEGIN
            u32x4* st = (u32x4*)(ws + WS_STASH + (size_t)blockIdx.x * 131072) + tid;
            const int gcol = (int)((u.B - (const char*)(ws + W_IN)) >> 11) + lc0;
            rowstat<16>(rs, ssq1, 1.f / 1024.f, 1.f, rbw, rsbuf, lane, fr);
            f32x4 bv[2][2];
#pragma unroll
            for (int bj = 0; bj < 2; ++bj)
#pragma unroll
                for (int n = 0; n < 2; ++n) bv[bj][n] = *(const f32x4*)(bias1 + bidx * NWIN + gcol + bj * 128 + n * 4);
#pragma unroll
            for (int ai = 0; ai < 2; ++ai)
#pragma unroll
                for (int m = 0; m < 4; ++m)
#pragma unroll
                    for (int bj = 0; bj < 2; ++bj) { f32x4 g0, g1;
                        const f32x4 a0 = acc[ai][bj][m][0] * rs[ai][m] + bv[bj][0], a1 = acc[ai][bj][m][1] * rs[ai][m] + bv[bj][1];
#pragma unroll
                        for (int e = 0; e < 4; ++e) { g0[e] = sigmoidf_(a0[e]); g1[e] = sigmoidf_(a1[e]); }
                        st[((ai * 4 + m) * 2 + bj) * 512] = PK8(g0, g1); }
        } break;
        case K_BR0: case K_BR1: case K_BR2: { EPI_CASE_BEGIN
            const u32x4* st = (const u32x4*)(ws + WS_STASH + (size_t)blockIdx.x * 131072) + tid; bf16_t* dst = (bf16_t*)(ws + WS_MERGED);
            const bool first = u.kind == K_BR0;
#pragma unroll
            for (int ai = 0; ai < 2; ++ai)
#pragma unroll
                for (int m = 0; m < 4; ++m) { const int row = row0 + ai * 128 + m * 16;
#pragma unroll
                    for (int bj = 0; bj < 2; ++bj) { const u32x4 g = st[((ai * 4 + m) * 2 + bj) * 512];
                        u32x4* d = (u32x4*)(dst + (size_t)row * 1024 + u.pn * 256 + lc0 + bj * 128);
                        const f32x4 a0 = acc[ai][bj][m][0], a1 = acc[ai][bj][m][1];
                        f32x4 r0 = {bf_lo(g.x) * a0[0], bf_hi(g.x) * a0[1], bf_lo(g.y) * a0[2], bf_hi(g.y) * a0[3]}, r1 = {bf_lo(g.z) * a1[0], bf_hi(g.z) * a1[1], bf_lo(g.w) * a1[2], bf_hi(g.w) * a1[3]};
                        if (!first) { const u32x4 o = *d; r0[0] += bf_lo(o.x); r0[1] += bf_hi(o.x); r0[2] += bf_lo(o.y); r0[3] += bf_hi(o.y); r1[0] += bf_lo(o.z); r1[1] += bf_hi(o.z); r1[2] += bf_lo(o.w); r1[3] += bf_hi(o.w); }
                        *d = PK8(r0, r1); } }
        } break;
        case K_OUT: case K_FF2: { EPI_CASE_BEGIN
            const bool isout = u.kind == K_OUT;
            const int goff = isout ? 2048 : 5120; const float* src = isout ? xin : out;
            const float* gn = isout ? g2 : g1n; const float* mn = isout ? mod + 4096 : modn + 1024;
            float* ssqo = isout ? ssq2 : ssqn; bf16_t* hd = (bf16_t*)(ws + WS_HDN);
            const bool lastff2 = !isout && (l + 1 == DEPTH);
            f32x4 gv[2][2], fac[2][2];
#pragma unroll
            for (int bj = 0; bj < 2; ++bj)
#pragma unroll
                for (int n = 0; n < 2; ++n) { const int col = u.pn * 256 + lc0 + bj * 128 + n * 4;
                    gv[bj][n] = *(const f32x4*)(mod + bidx * 6144 + goff + col);
                    fac[bj][n] = lastff2 ? (f32x4){1.f, 1.f, 1.f, 1.f} : *(const f32x4*)(gn + col) * (*(const f32x4*)(mn + bidx * 6144 + col) + 1.f); }
            bf16_t* xb = (bf16_t*)out;
            const bool f32res = isout && l == 0;
#pragma unroll
            for (int ai = 0; ai < 2; ++ai)
#pragma unroll
                for (int m = 0; m < 4; ++m) { __builtin_amdgcn_sched_barrier(0);
                    const size_t ro = (size_t)(row0 + ai * 128 + m * 16) * 1024 + u.pn * 256 + lc0; float sv = 0.f;
#pragma unroll
                    for (int bj = 0; bj < 2; ++bj) { const int co = bj * 128;
                        f32x4 r0, r1;
                        if (f32res) { r0 = *(const f32x4*)(src + ro + co); r1 = *(const f32x4*)(src + ro + co + 4); }
                        else { const u32x4 rb = *(const u32x4*)(xb + ro + co); r0 = (f32x4){bf_lo(rb.x), bf_hi(rb.x), bf_lo(rb.y), bf_hi(rb.y)}; r1 = (f32x4){bf_lo(rb.z), bf_hi(rb.z), bf_lo(rb.w), bf_hi(rb.w)}; }
                        const f32x4 x0 = r0 + gv[bj][0] * acc[ai][bj][m][0], x1 = r1 + gv[bj][1] * acc[ai][bj][m][1];
                        if (!lastff2) *(u32x4*)(xb + ro + co) = PK8(x0, x1);
                        sv += ((x0[0] * x0[0] + x0[1] * x0[1]) + (x0[2] * x0[2] + x0[3] * x0[3])) + ((x1[0] * x1[0] + x1[1] * x1[1]) + (x1[2] * x1[2] + x1[3] * x1[3]));
                        const f32x4 h0 = x0 * fac[bj][0], h1 = x1 * fac[bj][1];
                        *(u32x4*)(hd + ro + co) = PK8(h0, h1); }
                    sv += __shfl_xor(sv, 16); sv += __shfl_xor(sv, 32);
                    if (fq == 0) ssqo[(size_t)(row0 + ai * 128 + m * 16) * 16 + u.pn * 4 + wc] = sv; }
        } break;
        case K_FF1: { EPI_CASE_BEGIN
            bf16_t* dst = (bf16_t*)(ws + WS_H);
            rowstat<16>(rs, ssq2, 1.f / 1024.f, 1.f, rbw, rsbuf, lane, fr);
            f32x4 bv[2][2];
#pragma unroll
            for (int bj = 0; bj < 2; ++bj)
#pragma unroll
                for (int n = 0; n < 2; ++n) bv[bj][n] = *(const f32x4*)(bias2 + bidx * 4096 + u.pn * 256 + lc0 + bj * 128 + n * 4);
#pragma unroll
            for (int ai = 0; ai < 2; ++ai)
#pragma unroll
                for (int m = 0; m < 4; ++m) { const int row = row0 + ai * 128 + m * 16;
#pragma unroll
                    for (int bj = 0; bj < 2; ++bj) { f32x4 v0 = acc[ai][bj][m][0] * rs[ai][m] + bv[bj][0], v1 = acc[ai][bj][m][1] * rs[ai][m] + bv[bj][1];
#pragma unroll
                        for (int e = 0; e < 4; ++e) { const float t0 = fmaxf(v0[e], 0.f), t1 = fmaxf(v1[e], 0.f); v0[e] = t0 * t0; v1[e] = t1 * t1; }
                        *(u32x4*)(dst + (size_t)row * 4096 + u.pn * 256 + lc0 + bj * 128) = PK8(v0, v1); } }
        } break;
        }
    }
};

DI void gemm_phase(LAS unsigned char* lds, const Sched& S_, const Epi& E) {
    Sched S = S_; asm volatile("" : "+s"(S.c));
    const int tid = tid_opaque(), wid = __builtin_amdgcn_readfirstlane(tid >> 6), lane = tid & 63, wr = wid >> 2, wc = wid & 3, fr = lane & 15, fq = lane >> 4;
    int sR[2], sRb[2], sC[2];
#pragma unroll
    for (int i = 0; i < 2; ++i) { int R, C; stage_rc(tid * 16 + i * 8192, R, C); sR[i] = R; sRb[i] = (R & ~31) + perm32(R & 31); sC[i] = C * 2; }
    const size_t kstep = (size_t)(BK * 2);
    const unsigned ldsw = (unsigned)wid * 1024u;
    const int aoff = lds_byte(wr * 64 + fr, fq * 8), boff = lds_byte(wc * 32 + fr, fq * 8);
#define PG8_SA(b, h) (((b) * 2 + (h)) * HTB)
#define PG8_SB(b, h) ((4 + (b) * 2 + (h)) * HTB)
#define PG8_STAGE_(RR, bufoff, gbase, ld) do { _Pragma("unroll") for (int _i = 0; _i < 2; ++_i) \
        __builtin_amdgcn_global_load_lds((const unsigned*)((const char*)(gbase) + (unsigned)(RR[_i] * (ld) + sC[_i])), (LAS unsigned*)(lds + (bufoff) + ldsw + _i * 8192), 16, 0, 0); } while (0)
#define PG8_STAGE(bufoff, gbase, ld) do { if ((bufoff) >= 4 * HTB) PG8_STAGE_(sRb, bufoff, gbase, ld); else PG8_STAGE_(sR, bufoff, gbase, ld); } while (0)
#define PG8_LDA(dst, b, h) do { _Pragma("unroll") for (int m = 0; m < 4; ++m) _Pragma("unroll") for (int k = 0; k < 2; ++k) dst[m][k] = *(const LAS bf16x8*)(lds + PG8_SA(b, h) + aoff + m * 2048 + k * 1024); } while (0)
#define PG8_LDB(dst, b, h) do { _Pragma("unroll") for (int n = 0; n < 2; ++n) _Pragma("unroll") for (int k = 0; k < 2; ++k) dst[n][k] = *(const LAS bf16x8*)(lds + PG8_SB(b, h) + boff + n * 2048 + k * 1024); } while (0)
#define PG8_MMA(ai, bj, At, Bt) do { __builtin_amdgcn_s_setprio(1); _Pragma("unroll") for (int m = 0; m < 4; ++m) _Pragma("unroll") for (int n = 0; n < 2; ++n) _Pragma("unroll") for (int k = 0; k < 2; ++k) \
        acc[ai][bj][m][n] = __builtin_amdgcn_mfma_f32_16x16x32_bf16(Bt[n][k], At[m][k], acc[ai][bj][m][n], 0, 0, 0); __builtin_amdgcn_s_setprio(0); } while (0)
#define PG8_WAIT_V(n) asm volatile("s_waitcnt vmcnt(" #n ")" ::: "memory")
#define PG8_WAIT_L(n) asm volatile("s_waitcnt lgkmcnt(" #n ")" ::: "memory")
#define PG8_BAR __builtin_amdgcn_s_barrier()
#define PG8_SCHED __builtin_amdgcn_sched_barrier(0)
    Unit cur, nxt; int ui = 0;
    if (!S.next(0, cur)) return;
    f32x4 acc[2][2][4][2];
#pragma unroll
    for (int a = 0; a < 2; ++a)
#pragma unroll
        for (int b = 0; b < 2; ++b)
#pragma unroll
            for (int m = 0; m < 4; ++m)
#pragma unroll
                for (int n = 0; n < 2; ++n) acc[a][b][m][n] = (f32x4){0.f, 0.f, 0.f, 0.f};
    bf16x8 At[4][2], B0[2][2], B1[2][2];
    const char* cA = cur.A; const char* cB = cur.B; int clda = cur.lda, cldb = cur.ldb;
    {
        const size_t hA = (size_t)HALF * clda, hB = (size_t)HALF * cldb;
        PG8_STAGE(PG8_SB(0, 0), cB, cldb); PG8_STAGE(PG8_SB(0, 1), cB + hB, cldb); PG8_STAGE(PG8_SA(0, 0), cA, clda); PG8_STAGE(PG8_SA(0, 1), cA + hA, clda);
        if (wr == 1) PG8_BAR;
        PG8_WAIT_V(2); PG8_BAR;
        PG8_STAGE(PG8_SB(1, 0), cB + kstep, cldb); PG8_STAGE(PG8_SA(1, 0), cA + kstep, clda); PG8_STAGE(PG8_SB(1, 1), cB + hB + kstep, cldb);
        PG8_WAIT_V(6); PG8_BAR;
    }
    for (;;) {
        const bool has_next = S.next(ui + 1, nxt);
        const char* nA = has_next ? nxt.A : cA; const char* nB = has_next ? nxt.B : cB;
        const int nlda = has_next ? nxt.lda : clda, nldb = has_next ? nxt.ldb : cldb;
        const int nt = cur.nt;
        const size_t hA = (size_t)HALF * clda, hB = (size_t)HALF * cldb, nhA = (size_t)HALF * nlda, nhB = (size_t)HALF * nldb;
        for (int t = 0; t < nt; t += 2) {
            const bool last = (t == nt - 2);
            const char* a1 = cA + (size_t)(t + 1) * kstep;
            const char* a2 = last ? nA : cA + (size_t)(t + 2) * kstep; const char* b2 = last ? nB : cB + (size_t)(t + 2) * kstep;
            const char* a3 = a2 + kstep; const char* b3 = b2 + kstep;
            const int l2a = last ? nlda : clda, l2b = last ? nldb : cldb; const size_t h2a = last ? nhA : hA, h2b = last ? nhB : hB;
            PG8_LDB(B0, 0, 0); PG8_LDB(B1, 0, 1); PG8_SCHED; PG8_LDA(At, 0, 0); PG8_STAGE(PG8_SA(1, 1), a1 + hA, clda);
            PG8_WAIT_V(8); PG8_WAIT_L(0); PG8_BAR; PG8_MMA(0, 0, At, B0); PG8_MMA(0, 1, At, B1); PG8_BAR; PG8_SCHED;
            PG8_LDA(At, 0, 1); PG8_STAGE(PG8_SB(0, 0), b2, l2b); PG8_STAGE(PG8_SB(0, 1), b2 + h2b, l2b); PG8_STAGE(PG8_SA(0, 0), a2, l2a);
            PG8_WAIT_V(8); PG8_WAIT_L(0); PG8_BAR; PG8_MMA(1, 0, At, B0); PG8_MMA(1, 1, At, B1); PG8_BAR; PG8_SCHED;
            PG8_LDB(B0, 1, 0); PG8_LDB(B1, 1, 1); PG8_SCHED; PG8_LDA(At, 1, 0); PG8_STAGE(PG8_SA(0, 1), a2 + h2a, l2a);
            PG8_WAIT_V(8); PG8_WAIT_L(0); PG8_BAR; PG8_MMA(0, 0, At, B0); PG8_MMA(0, 1, At, B1); PG8_BAR; PG8_SCHED;
            PG8_LDA(At, 1, 1); PG8_STAGE(PG8_SB(1, 0), b3, l2b); PG8_STAGE(PG8_SB(1, 1), b3 + h2b, l2b); PG8_STAGE(PG8_SA(1, 0), a3, l2a);
            PG8_WAIT_V(8); PG8_WAIT_L(0); PG8_BAR; PG8_MMA(1, 0, At, B0); PG8_MMA(1, 1, At, B1); PG8_BAR; PG8_SCHED;
        }
        if (wr == 0) PG8_BAR;
        E(acc, cur, wr, wc, fr, fq, tid, lds);
        if (!has_next) break;
#pragma unroll
        for (int a = 0; a < 2; ++a)
#pragma unroll
            for (int b = 0; b < 2; ++b)
#pragma unroll
                for (int m = 0; m < 4; ++m)
#pragma unroll
                    for (int n = 0; n < 2; ++n) acc[a][b][m][n] = (f32x4){0.f, 0.f, 0.f, 0.f};
        cur = nxt; cA = nA; cB = nB; clda = nlda; cldb = nldb; ++ui;
        if (wr == 1) PG8_BAR;
    }
    PG8_WAIT_V(0);
    PG8_BAR;
#undef PG8_SA
#undef PG8_SB
#undef PG8_STAGE
#undef PG8_STAGE_
#undef PG8_LDA
#undef PG8_LDB
#undef PG8_MMA
#undef PG8_WAIT_V
#undef PG8_WAIT_L
#undef PG8_BAR
#undef PG8_SCHED
}
}

#define MFMA32(a, b, c) __builtin_amdgcn_mfma_f32_32x32x16_bf16((a), (b), (c), 0, 0, 0)
DI int crow(int i, int h) { return (i & 3) + 8 * (i >> 2) + 4 * h; }
typedef short v4i16_t __attribute__((ext_vector_type(4)));
DI s16x4 tr_read(const LAS unsigned char* p) { return __builtin_bit_cast(s16x4, __builtin_amdgcn_ds_read_tr16_b64_v4i16((LAS v4i16_t*)p)); }
DI float swap_max(float m) { auto rr = __builtin_amdgcn_permlane32_swap(__float_as_uint(m), __float_as_uint(m), false, false); return fmaxf(__uint_as_float(rr[0]), __uint_as_float(rr[1])); }
DI float swap_sum(float m) { auto rr = __builtin_amdgcn_permlane32_swap(__float_as_uint(m), __float_as_uint(m), false, false); return __uint_as_float(rr[0]) + __uint_as_float(rr[1]); }
DI bf16x8 pack8(const f32x16& x, int s) {
    u32x4 p; p[0] = pk2(x[8 * s], x[8 * s + 1]); p[1] = pk2(x[8 * s + 2], x[8 * s + 3]); p[2] = pk2(x[8 * s + 4], x[8 * s + 5]); p[3] = pk2(x[8 * s + 6], x[8 * s + 7]);
    return __builtin_bit_cast(bf16x8, p);
}

DI float max3f(float a, float b, float c) { float r; asm("v_max3_f32 %0, %1, %2, %3" : "=v"(r) : "v"(a), "v"(b), "v"(c)); return r; }
DI float max2f(float a, float b) { float r; asm("v_max_f32_e32 %0, %1, %2" : "=v"(r) : "v"(a), "v"(b)); return r; }
DI float rowmax32(const f32x16& p0, const f32x16& p1) {
    float a = max3f(p0[0], p0[1], p1[0]), b = max3f(p0[2], p0[3], p1[1]); a = max3f(a, p1[2], p1[3]);
#pragma unroll
    for (int r = 4; r < 16; r += 4) { a = max3f(a, p0[r], p0[r + 1]); b = max3f(b, p0[r + 2], p0[r + 3]); a = max3f(a, p1[r], p1[r + 1]); b = max3f(b, p1[r + 2], p1[r + 3]); }
    const float m = max2f(a, b);
    auto rr = __builtin_amdgcn_permlane32_swap(__float_as_uint(m), __float_as_uint(m), false, false);
    return max2f(__uint_as_float(rr[0]), __uint_as_float(rr[1]));
}
constexpr int AT_K0 = 0, AT_K1 = 16384, AT_V0 = 32768, AT_V1 = 49152, AT_SEL = 65536, AT_MISC = 66560 + 1024, AT_FLAG = 66560 + 2048;
constexpr int VP = 144;

template <int MODE>
DI void attn_unit(unsigned char* ws, int b, int h, int qb, LAS unsigned char* lds, bool do_store = true) {
    constexpr int DQK = MODE == 0 ? 96 : 64, NS = DQK / 16, KP = DQK * 2 + 16;
    constexpr int QPITCH = MODE == 0 ? 768 : 1536, KPITCH = MODE == 0 ? 1024 : 1536, OPITCH = MODE == 0 ? 512 : 1536;
    const bf16_t* Qb = (const bf16_t*)(ws + (MODE == 0 ? WS_QMLA : (MODE == 1 ? WS_SB : WS_MB)));
    const bf16_t* Kb = (const bf16_t*)(ws + (MODE == 0 ? WS_KVMLA : (MODE == 1 ? WS_SB : WS_MB)));
    bf16_t* Ob = (bf16_t*)(ws + (MODE == 0 ? WS_OMLA : (MODE == 1 ? WS_SB : WS_MB)));
    const bf16_t* KPEb = (const bf16_t*)(ws + WS_KPE);
    const int qcol = MODE == 0 ? h * 96 : h * 64, kcol = MODE == 0 ? h * 128 : 512 + h * 64, vcol = MODE == 0 ? h * 128 + 64 : 1024 + h * 64, ocol = h * 64;
    const int tid = tid_opaque(), lane = tid & 63, w = __builtin_amdgcn_readfirstlane(tid >> 6), r = lane & 31, hh = lane >> 5;
    const int q0 = qb * 256; const long rowbase = (long)b * SEQ;
    const int qg = q0 + 32 * w + r;
    bf16x8 qf[NS];
    { const bf16_t* qrow = Qb + (size_t)(rowbase + qg) * QPITCH + qcol + 8 * hh;
#pragma unroll
      for (int s = 0; s < NS; ++s) qf[s] = *(const bf16x8*)(qrow + 16 * s); }
    unsigned mysel = 0;
    if (MODE == 2) {
        if (tid < 256) {
            const bf16_t* qr = Qb + (size_t)(rowbase + q0 + tid) * QPITCH + qcol;
            float qv[64];
#pragma unroll
            for (int c8 = 0; c8 < 8; ++c8) { const u32x4 u = *(const u32x4*)(qr + c8 * 8);
#pragma unroll
                for (int e = 0; e < 4; ++e) { qv[c8 * 8 + 2 * e] = bf_lo(u[e]); qv[c8 * 8 + 2 * e + 1] = bf_hi(u[e]); } }
            const float* km = (const float*)(ws + WS_KMEAN) + (size_t)((b * 8 + h) * 16) * 64;
            float v0 = -INFINITY, v1 = -INFINITY, v2 = -INFINITY; int i0 = -1, i1 = -1, i2 = -1;
            for (int n = 0; n < qb; ++n) { float d = 0.f;
#pragma unroll
                for (int e = 0; e < 64; ++e) d += qv[e] * km[n * 64 + e];
                if (d > v0) { v2 = v1; i2 = i1; v1 = v0; i1 = i0; v0 = d; i0 = n; }
                else if (d > v1) { v2 = v1; i2 = i1; v1 = d; i1 = n; }
                else if (d > v2) { v2 = d; i2 = n; } }
            unsigned mk = 0; if (i0 >= 0) mk |= 1u << i0; if (i1 >= 0) mk |= 1u << i1; if (i2 >= 0) mk |= 1u << i2;
            *(LAS unsigned*)(lds + AT_SEL + tid * 4) = mk;
        }
        __syncthreads();
        mysel = *(LAS unsigned*)(lds + AT_SEL + (32 * w + r) * 4);
    }
    const int kkey = tid >> 3, kch = tid & 7, pkey = (tid & 255) >> 2, pch = tid & 3;
    u32x4 kr[2], vr[2], pr[2];
    pr[0] = (u32x4){0u, 0u, 0u, 0u}; pr[1] = pr[0];
#define AT_LOADG(kt, R) do { const size_t krow_ = (size_t)(rowbase + (kt) * 64 + kkey); \
        kr[R] = *(const u32x4*)(Kb + krow_ * KPITCH + kcol + kch * 8); vr[R] = *(const u32x4*)(Kb + krow_ * KPITCH + vcol + kch * 8); \
        if (MODE == 0 && tid < 256) pr[R] = *(const u32x4*)(KPEb + (size_t)(rowbase + (kt) * 64 + pkey) * 32 + pch * 8); } while (0)
#define AT_STORE(bf, R) do { *(LAS u32x4*)(lds + ((bf) ? AT_K1 : AT_K0) + kkey * KP + kch * 16) = kr[R]; *(LAS u32x4*)(lds + ((bf) ? AT_V1 : AT_V0) + kkey * VP + kch * 16) = vr[R]; \
        if (MODE == 0 && tid < 256) *(LAS u32x4*)(lds + ((bf) ? AT_K1 : AT_K0) + pkey * KP + 128 + pch * 16) = pr[R]; } while (0)
    const int kt_hi = qb * 4 + 3;
    AT_LOADG(kt_hi, 0); AT_LOADG(kt_hi - 1, 1); AT_STORE(0, 0);
    __syncthreads();
    f32x16 o0, o1;
#pragma unroll
    for (int i = 0; i < 16; ++i) { o0[i] = 0.f; o1[i] = 0.f; }
    float carry = 0.f; bool first = true;
    f32x16 lacc;
#pragma unroll
    for (int i = 0; i < 16; ++i) lacc[i] = 0.f;
    float refv = 0.f;
    const short kx0 = (hh == 0) ? (short)0xBF80 : (short)0;
    const bf16x8 kx = {kx0, 0, 0, 0, 0, 0, 0, 0};
    bf16x8 qx = {0, 0, 0, 0, 0, 0, 0, 0};
    const bf16x8 qbig = {(hh == 0) ? (short)0x7149 : (short)0, 0, 0, 0, 0, 0, 0, 0};
    f32x16 zero16;
#pragma unroll
    for (int i = 0; i < 16; ++i) zero16[i] = 0.f;
    const bf16x8 ones = {(short)0x3F80, (short)0x3F80, (short)0x3F80, (short)0x3F80, (short)0x3F80, (short)0x3F80, (short)0x3F80, (short)0x3F80};
    const int i16 = lane & 15, tq = i16 >> 2, tp = i16 & 3, blk = (lane >> 4) & 1;
    const int voff = (4 * hh + tq) * VP + (16 * blk + 4 * tp) * 2;
    const int qmin_w = q0 + 32 * w, qmax_w = qmin_w + 31;
    bool wfin = false, fin = false;
    int kt = kt_hi;
    for (;;) {
#pragma unroll
      for (int half = 0; half < 2; ++half) {
        if (kt >= 2) AT_LOADG(kt - 2, half);
        if (kt * 64 <= qmax_w && !wfin) {
            const LAS unsigned char* kb = lds + (half ? AT_K1 : AT_K0) + r * KP + hh * 16;
            f32x16 p0, p1;
#pragma unroll
            for (int s = 0; s < NS; ++s) {
                const bf16x8 k0 = *(const LAS bf16x8*)(kb + s * 32), k1 = *(const LAS bf16x8*)(kb + 32 * KP + s * 32);
                if (s == 0) { p0 = MFMA32(k0, qf[s], zero16); p1 = MFMA32(k1, qf[s], zero16); }
                else { p0 = MFMA32(k0, qf[s], p0); p1 = MFMA32(k1, qf[s], p1); }
            }
            if (MODE != 1) {
                bf16x8 qe = qx;
                if (MODE == 2) { const int nbk = kt >> 2; const bool dead = (nbk < qb) && !((mysel >> nbk) & 1u); qe = dead ? qbig : qx; }
                p0 = MFMA32(kx, qe, p0); p1 = MFMA32(kx, qe, p1);
            }
            bf16x8 vaf[4][2];
            { const LAS unsigned char* vb = lds + (half ? AT_V1 : AT_V0) + voff;
#pragma unroll
              for (int f = 0; f < 4; ++f) { const LAS unsigned char* vp = vb + (16 * f) * VP;
                  { const s16x4 lo = tr_read(vp), hi = tr_read(vp + 8 * VP); vaf[f][0] = __builtin_shufflevector(lo, hi, 0, 1, 2, 3, 4, 5, 6, 7); }
                  { const s16x4 lo = tr_read(vp + 64), hi = tr_read(vp + 8 * VP + 64); vaf[f][1] = __builtin_shufflevector(lo, hi, 0, 1, 2, 3, 4, 5, 6, 7); } } }
#define AT_PV(f, P, S2) do { const bf16x8 pf_ = pack8(P, S2); o0 = MFMA32(vaf[f][0], pf_, o0); o1 = MFMA32(vaf[f][1], pf_, o1); if (MODE != 1) lacc = MFMA32(ones, pf_, lacc); } while (0)
            const bool needmask = (kt * 64 + 63 >= qmin_w);
            const int kbase = kt * 64;
            if (MODE == 1) {
                f32x16 k0v, k1v;
#pragma unroll
                for (int i = 0; i < 16; ++i) {
                    { const float z = p0[i]; const float sp = fast_log(1.f + fast_exp(-fabsf(z))); float lb = fminf(z, 0.f) - sp; float lk = lb - z;
                      if (needmask && !(kbase + crow(i, hh) < qg)) { lb = -INFINITY; lk = 0.f; } p0[i] = lb; k0v[i] = lk; }
                    { const float z = p1[i]; const float sp = fast_log(1.f + fast_exp(-fabsf(z))); float lb = fminf(z, 0.f) - sp; float lk = lb - z;
                      if (needmask && !(kbase + 32 + crow(i, hh) < qg)) { lb = -INFINITY; lk = 0.f; } p1[i] = lb; k1v[i] = lk; }
                }
                float run = carry;
#pragma unroll
                for (int u = 7; u >= 0; --u) {
                    const int g = u & 3;
                    float gs = (u >= 4) ? ((k1v[4 * g] + k1v[4 * g + 1]) + (k1v[4 * g + 2] + k1v[4 * g + 3])) : ((k0v[4 * g] + k0v[4 * g + 1]) + (k0v[4 * g + 2] + k0v[4 * g + 3]));
                    auto rr = __builtin_amdgcn_permlane32_swap(__float_as_uint(gs), __float_as_uint(gs), false, false);
                    const float glo = __uint_as_float(rr[0]), ghi = __uint_as_float(rr[1]);
                    float a = run + (hh == 0 ? ghi : 0.f);
#pragma unroll
                    for (int jj = 3; jj >= 0; --jj) {
                        if (u >= 4) { const float lb = p1[4 * g + jj]; p1[4 * g + jj] = fast_exp(lb + a); a += k1v[4 * g + jj]; }
                        else { const float lb = p0[4 * g + jj]; p0[4 * g + jj] = fast_exp(lb + a); a += k0v[4 * g + jj]; }
                    }
                    run += glo + ghi;
                    if (u == 6) AT_PV(3, p1, 1); else if (u == 4) AT_PV(2, p1, 0); else if (u == 2) AT_PV(1, p0, 1); else if (u == 0) AT_PV(0, p0, 0);
                }
                carry = run;
                wfin = __all(carry < -110.f);
            } else {
                if (needmask) {
#pragma unroll
                    for (int i = 0; i < 16; ++i) { if (kbase + crow(i, hh) > qg) p0[i] = -INFINITY; if (kbase + 32 + crow(i, hh) > qg) p1[i] = -INFINITY; }
                }
                const float mt = rowmax32(p0, p1);
                if (first || __any(mt > 8.f)) {
                    const float delta = first ? (mt > -1e30f ? mt : 0.f) : (mt > 8.f ? mt : 0.f);
                    const unsigned nb16 = pk2(refv + delta, 0.f) & 0xffffu; const float nref = __uint_as_float(nb16 << 16);
                    const float d2 = nref - refv; const float sc = fast_exp2(-d2);
#pragma unroll
                    for (int i = 0; i < 16; ++i) { p0[i] -= d2; p1[i] -= d2; o0[i] *= sc; o1[i] *= sc; lacc[i] *= sc; }
                    refv = nref; qx[0] = (hh == 0) ? (short)nb16 : (short)0;
                    first = false;
                }
#pragma unroll
                for (int i = 0; i < 8; ++i) p0[i] = fast_exp2(p0[i]);
                AT_PV(0, p0, 0);
#pragma unroll
                for (int i = 8; i < 16; ++i) p0[i] = fast_exp2(p0[i]);
                AT_PV(1, p0, 1);
#pragma unroll
                for (int i = 0; i < 8; ++i) p1[i] = fast_exp2(p1[i]);
                AT_PV(2, p1, 0);
#pragma unroll
                for (int i = 8; i < 16; ++i) p1[i] = fast_exp2(p1[i]);
                AT_PV(3, p1, 1);
            }
#undef AT_PV
        }
        if (kt >= 1) AT_STORE(half ^ 1, half ^ 1);
        if (MODE == 1 && lane == 0) *(LAS unsigned*)(lds + AT_FLAG + half * 32 + w * 4) = wfin ? 1u : 0u;
        asm volatile("s_waitcnt lgkmcnt(0)" ::: "memory"); __builtin_amdgcn_s_barrier(); asm volatile("" ::: "memory");
        if (MODE == 1) { const u32x4 fa = *(const LAS u32x4*)(lds + AT_FLAG + half * 32), fb = *(const LAS u32x4*)(lds + AT_FLAG + half * 32 + 16);
            if ((fa.x & fa.y & fa.z & fa.w & fb.x & fb.y & fb.z & fb.w) != 0u) { fin = true; break; } }
        if (kt == 0) { fin = true; break; }
        --kt;
      }
      if (fin) break;
    }
    if (MODE != 1) { const float inv = 1.f / lacc[0];
#pragma unroll
        for (int i = 0; i < 16; ++i) { o0[i] *= inv; o1[i] *= inv; } }
    bf16_t* orow = Ob + (size_t)(rowbase + qg) * OPITCH + ocol + 4 * hh;
    if (do_store)
#pragma unroll
    for (int g = 0; g < 4; ++g) {
        u32x2 a, c; a.x = pk2(o0[4 * g], o0[4 * g + 1]); a.y = pk2(o0[4 * g + 2], o0[4 * g + 3]); c.x = pk2(o1[4 * g], o1[4 * g + 1]); c.y = pk2(o1[4 * g + 2], o1[4 * g + 3]);
        *(u32x2*)(orow + 8 * g) = a; *(u32x2*)(orow + 32 + 8 * g) = c;
    }
#undef AT_LOADG
#undef AT_STORE
}

DI void attn_phase(unsigned char* ws, LAS unsigned char* lds, unsigned* ctr, bool never) {
    const int tid = tid_opaque();
    for (;;) {
        __syncthreads();
        if (tid == 0) *(LAS int*)(lds + AT_MISC) = (int)atomicAdd(ctr, 1u);
        __syncthreads();
        const int u = *(LAS int*)(lds + AT_MISC);
        if (u >= 3072) break;
        if (u < 2048) { const int qb = 15 - (u >> 7), rem = u & 127, ty = rem >> 6, bh = rem & 63;
#ifdef PROBE_ATT2
            if (ty == 0) { attn_unit<0>(ws, bh >> 3, bh & 7, qb, lds, never); __syncthreads(); } else { attn_unit<2>(ws, bh >> 3, bh & 7, qb, lds, never); __syncthreads(); }
#endif
            if (ty == 0) attn_unit<0>(ws, bh >> 3, bh & 7, qb, lds); else attn_unit<2>(ws, bh >> 3, bh & 7, qb, lds); }
        else { const int v = u - 2048, qb = 15 - (v >> 6), bh = v & 63;
#ifdef PROBE_ATT2
            attn_unit<1>(ws, bh >> 3, bh & 7, qb, lds, never); __syncthreads();
#endif
            attn_unit<1>(ws, bh >> 3, bh & 7, qb, lds); }
    }
}

DI void cvt_T(const float* in, int K, int N, int ldin, bf16_t* out, int ldout, const float* gk, LAS float* tile, int& off) {
    const int tid = tid_opaque(), G = gridDim.x, kts = K / 64, nts = N / 32, ntile = kts * nts;
    for (int t = (int)((blockIdx.x + G - (off % G)) % G); t < ntile; t += G) {
        const int k0 = (t % kts) * 64, n0 = (t / kts) * 32;
#pragma unroll
        for (int i = 0; i < 4; ++i) { const int kl = (tid >> 5) + 16 * i, nl = tid & 31; float v = in[(size_t)(k0 + kl) * ldin + n0 + nl]; if (gk) v *= gk[k0 + kl]; tile[kl * 33 + nl] = v; }
        __syncthreads();
#pragma unroll
        for (int i = 0; i < 2; ++i) { const int nl = (tid >> 5) + 16 * i, kp = tid & 31;
            *(unsigned*)(out + (size_t)(n0 + nl) * ldout + k0 + 2 * kp) = pk2(tile[(2 * kp) * 33 + nl], tile[(2 * kp + 1) * 33 + nl]); }
        __syncthreads();
    }
    off += ntile;
}

DI void phase_bias(const Params& p, int l, LAS unsigned char* lds) {
    const int tid = tid_opaque(), lane = tid & 63, w = tid >> 6; unsigned char* ws = p.ws;
    LAS float* sh = (LAS float*)lds;
    LAS float* red = (LAS float*)(lds + 65536);
    const float* modl = (const float*)(ws + WS_MOD) + (size_t)l * 8 * 6144;
    bool staged = false;
    for (int it = (int)((blockIdx.x + 128) % gridDim.x); it < 177; it += gridDim.x) {
        if (!staged) { for (int i = tid; i < 8192; i += NTHREADS) { sh[i] = modl[(i >> 10) * 6144 + (i & 1023)]; sh[8192 + i] = modl[(i >> 10) * 6144 + 3072 + (i & 1023)]; } staged = true; }
        __syncthreads();
        const bool isin = it < 113; const int n = (isin ? it : it - 113) * 64 + lane; const int ld = isin ? 7200 : 4096; const bool valid = n < ld;
        const float* wa = (isin ? p.w_in + (size_t)l * 1024 * 7200 : p.w_ff1 + (size_t)l * 1024 * 4096) + (valid ? n : 0);
        const LAS float* shp = sh + (isin ? 0 : 8192);
        float a[8];
#pragma unroll
        for (int b = 0; b < 8; ++b) a[b] = 0.f;
#pragma unroll 16
        for (int k = w * 128; k < w * 128 + 128; ++k) { const float wv = wa[(size_t)k * ld];
#pragma unroll
            for (int b = 0; b < 8; ++b) a[b] += shp[b * 1024 + k] * wv; }
#pragma unroll
        for (int b = 0; b < 8; ++b) red[(w * 8 + b) * 64 + lane] = a[b];
        __syncthreads();
        { const int b = w; float sacc = 0.f;
#pragma unroll
          for (int ww = 0; ww < 8; ++ww) sacc += red[(ww * 8 + b) * 64 + lane];
          if (valid) { if (isin) ((float*)(ws + WS_BIAS1))[(size_t)(l * 8 + b) * NWIN + (n < 1056 ? n : n + 224)] = sacc; else ((float*)(ws + WS_BIAS2))[(size_t)(l * 8 + b) * 4096 + n] = sacc; } }
        __syncthreads();
    }
}

DI void phase_convert(const Params& p, int l, LAS unsigned char* lds) {
    LAS float* tile = (LAS float*)lds; unsigned char* ws = p.ws; int off = 0;
    const float* win = p.w_in + (size_t)l * 1024 * 7200;
    cvt_T(win, 1024, 1056, 7200, (bf16_t*)(ws + W_IN), 1024, nullptr, tile, off);
    cvt_T(win + 1056, 1024, 6144, 7200, (bf16_t*)(ws + W_IN) + (size_t)1280 * 1024, 1024, nullptr, tile, off);
    { u32x4* z = (u32x4*)((bf16_t*)(ws + W_IN) + (size_t)1056 * 1024); const int n = 224 * 1024 * 2 / 16;
      for (int i = blockIdx.x * NTHREADS + tid_opaque(); i < n; i += gridDim.x * NTHREADS) z[i] = (u32x4){0u, 0u, 0u, 0u}; }
    cvt_T(p.w_uq + (size_t)l * 768 * 768, 768, 768, 768, (bf16_t*)(ws + W_UQ), 768, p.q_norm_g + l * 768, tile, off);
    cvt_T(p.w_ukv + (size_t)l * 256 * 1024, 256, 1024, 1024, (bf16_t*)(ws + W_UKV), 256, p.kv_norm_g + l * 256, tile, off);
    cvt_T(p.w_o_mla + (size_t)l * 512 * 1024, 512, 1024, 1024, (bf16_t*)(ws + W_O), 512, nullptr, tile, off);
    cvt_T(p.w_o_sb + (size_t)l * 512 * 1024, 512, 1024, 1024, (bf16_t*)(ws + W_O) + (size_t)1024 * 512, 512, nullptr, tile, off);
    cvt_T(p.w_o_moba + (size_t)l * 512 * 1024, 512, 1024, 1024, (bf16_t*)(ws + W_O) + (size_t)2048 * 512, 512, nullptr, tile, off);
    cvt_T(p.w_out + (size_t)l * 1024 * 1024, 1024, 1024, 1024, (bf16_t*)(ws + W_OUT), 1024, nullptr, tile, off);
    cvt_T(p.w_ff1 + (size_t)l * 1024 * 4096, 1024, 4096, 4096, (bf16_t*)(ws + W_FF1), 1024, nullptr, tile, off);
    cvt_T(p.w_ff2 + (size_t)l * 4096 * 1024, 4096, 1024, 1024, (bf16_t*)(ws + W_FF2), 4096, nullptr, tile, off);
}

DI void phase_pre(const float* xin, const float* g, const float* modl, bf16_t* hdn, float* ssq) {
    const int tid = tid_opaque(), lane = tid & 63, w = tid >> 6;
    for (int row = blockIdx.x * 16 + w * 2; row < T; row += gridDim.x * 16) {
        f32x4 v[2][4];
#pragma unroll
        for (int rr = 0; rr < 2; ++rr) { const f32x4* xr = (const f32x4*)(xin + (size_t)(row + rr) * 1024) + lane;
#pragma unroll
            for (int j = 0; j < 4; ++j) v[rr][j] = xr[64 * j]; }
#pragma unroll
        for (int rr = 0; rr < 2; ++rr) { float s = 0.f;
#pragma unroll
            for (int j = 0; j < 4; ++j) s += (v[rr][j][0] * v[rr][j][0] + v[rr][j][1] * v[rr][j][1]) + (v[rr][j][2] * v[rr][j][2] + v[rr][j][3] * v[rr][j][3]);
            s = wave_sum(s); if (lane < 16) ssq[(size_t)(row + rr) * 16 + lane] = lane == 0 ? s : 0.f;
            const float* mb = modl + ((row + rr) >> 12) * 6144 + 1024;
#pragma unroll
            for (int j = 0; j < 4; ++j) { const int col = 4 * (lane + 64 * j);
                const f32x4 gg = *(const f32x4*)(g + col), sc = *(const f32x4*)(mb + col);
                *(u32x2*)(hdn + (size_t)(row + rr) * 1024 + col) = pk4(v[rr][j] * gg * (sc + 1.f)); } }
    }
}
DI void phase_final(float* xo, const bf16_t* xb, const float* g, const float* ssq) {
    const int tid = tid_opaque();
    for (int i = blockIdx.x * NTHREADS + tid; i < T * 128; i += gridDim.x * NTHREADS) {
        const int row = i >> 7, col = (i & 127) * 8; const float rstd = 1.f / sqrtf(sum16(ssq + (size_t)row * 16) * (1.f / 1024.f) + EPS);
        const u32x4 u = *(const u32x4*)(xb + (size_t)row * 1024 + col); const f32x4 g0 = *(const f32x4*)(g + col), g1 = *(const f32x4*)(g + col + 4);
        f32x4 a = {bf_lo(u.x), bf_hi(u.x), bf_lo(u.y), bf_hi(u.y)}, b = {bf_lo(u.z), bf_hi(u.z), bf_lo(u.w), bf_hi(u.w)};
        *(f32x4*)(xo + (size_t)row * 1024 + col) = (a * rstd) * g0; *(f32x4*)(xo + (size_t)row * 1024 + col + 4) = (b * rstd) * g1;
    }
}

DI void phase0(const Params& p, LAS unsigned char* lds) {
    const int tid = tid_opaque(), lane = tid & 63, w = tid >> 6; unsigned char* ws = p.ws;
    if (blockIdx.x == 0 && tid < 64) ((unsigned*)(ws + WS_CTR))[tid] = 0u;
    LAS float* cs = (LAS float*)lds;
    LAS float* red = (LAS float*)(lds + 32768);
    bool staged = false;
    for (int it = blockIdx.x; it < 192; it += gridDim.x) {
        if (!staged) { for (int i = tid; i < 8192; i += NTHREADS) { const float cv = p.c[i]; cs[i] = cv / (1.f + __expf(-cv)); } staged = true; }
        __syncthreads();
        const int l = it / 96, n = (it % 96) * 64 + lane;
        const float* wa = p.w_ada + (size_t)l * 1024 * 6144 + n;
        float a[8];
#pragma unroll
        for (int b = 0; b < 8; ++b) a[b] = 0.f;
#pragma unroll 16
        for (int k = w * 128; k < w * 128 + 128; ++k) { const float wv = wa[(size_t)k * 6144];
#pragma unroll
            for (int b = 0; b < 8; ++b) a[b] += cs[b * 1024 + k] * wv; }
#pragma unroll
        for (int b = 0; b < 8; ++b) red[(w * 8 + b) * 64 + lane] = a[b];
        __syncthreads();
        { const int b = w; float s = p.b_ada[l * 6144 + n];
#pragma unroll
          for (int ww = 0; ww < 8; ++ww) s += red[(ww * 8 + b) * 64 + lane];
          ((float*)(ws + WS_MOD))[(size_t)(l * 8 + b) * 6144 + n] = s; }
        __syncthreads();
    }
    const float L2T = 18.931568569324174f;
    float* rm = (float*)(ws + WS_ROPEM); float* rb = (float*)(ws + WS_ROPEB);
    for (int i = blockIdx.x * NTHREADS + tid; i < T * 24; i += gridDim.x * NTHREADS) {
        const int tok = i / 24, j = i % 24; const float ps = (float)p.pos[tok];
        float inv; if (j < 16) inv = exp2f(-(float)j * (L2T / 16.f)); else inv = exp2f(-(float)(j - 16) * (L2T / 8.f));
        const float ang = ps * inv; const double rev = (double)ang * 0.15915494309189535; const float fr = (float)(rev - rint(rev));
        const float sn = __builtin_amdgcn_sinf(fr), cn = __builtin_amdgcn_cosf(fr);
        if (j < 16) { rm[(size_t)tok * 32 + j] = cn; rm[(size_t)tok * 32 + 16 + j] = sn; } else { rb[(size_t)tok * 16 + (j - 16)] = cn; rb[(size_t)tok * 16 + 8 + (j - 16)] = sn; }
    }
}

DI void phase_kmean(unsigned char* ws, LAS unsigned char* lds) {
    const int tid = tid_opaque(); LAS float* red = (LAS float*)lds;
    const bf16_t* mb = (const bf16_t*)(ws + WS_MB); float* km = (float*)(ws + WS_KMEAN);
    for (int it = blockIdx.x; it < 1024; it += gridDim.x) {
        const int b = it >> 7, h = (it >> 4) & 7, nb = it & 15, c8 = tid & 7, j0 = tid >> 3;
        float s[8];
#pragma unroll
        for (int e = 0; e < 8; ++e) s[e] = 0.f;
#pragma unroll
        for (int jj = 0; jj < 4; ++jj) { const size_t row = (size_t)b * SEQ + nb * 256 + j0 + 64 * jj; const u32x4 u = *(const u32x4*)(mb + row * 1536 + 512 + h * 64 + c8 * 8);
#pragma unroll
            for (int e = 0; e < 4; ++e) { s[2 * e] += bf_lo(u[e]); s[2 * e + 1] += bf_hi(u[e]); } }
#pragma unroll
        for (int e = 0; e < 8; ++e) red[j0 * 65 + c8 * 8 + e] = s[e];
        __syncthreads();
        if (tid < 64) { float t = 0.f; for (int j = 0; j < 64; ++j) t += red[j * 65 + tid]; km[(size_t)it * 64 + tid] = t * (1.f / 256.f); }
        __syncthreads();
    }
}

#define XB_TMO      128
#define XB_XCNT(j)  (256  + 64 * (j))
#define XB_XSUB(j)  (1280 + 64 * (j))
#define XB_XGEN(j)  (2304 + 64 * (j))
#define XB_TOP      3328
#define XB_TOPGEN   3392
#define XCD_BAR_WORDS 3456
#define XB_SPIN_CAP (1u << 22)
DI unsigned xb_ld(unsigned* p)              { return __hip_atomic_load(p, __ATOMIC_RELAXED, __HIP_MEMORY_SCOPE_AGENT); }
DI unsigned xb_add(unsigned* p, unsigned v) { return __hip_atomic_fetch_add(p, v, __ATOMIC_RELAXED, __HIP_MEMORY_SCOPE_AGENT); }
DI unsigned xb_xcc_id() { return (unsigned)__builtin_amdgcn_s_getreg((3 << 11) | 20) & 0xFu; }
#define XB_SPIN(cond, bar) do { unsigned _sp = 0; while (cond) { __builtin_amdgcn_s_sleep(1); \
    if ((++_sp & 255u) == 0u) { if (xb_ld(&(bar)[XB_TMO])) break; if (_sp > XB_SPIN_CAP) { atomicAdd(&(bar)[XB_TMO], 1u); break; } } } } while (0)
struct XcdBarrier { unsigned* bar; unsigned x; volatile LAS unsigned* st; };
DI XcdBarrier xcd_barrier_post(unsigned* bar, volatile LAS unsigned* st) {
    XcdBarrier b; b.bar = bar; b.x = xb_xcc_id(); b.st = st;
    if (threadIdx.x == 0) (void)xb_add(&bar[XB_XCNT(b.x)], 1u);
    return b;
}
DI void xcd_barrier_complete(unsigned* bar, unsigned x, unsigned& nloc, unsigned& nx) {
    const unsigned G = gridDim.x * gridDim.y * gridDim.z;
    unsigned sum, cnt, mine, sp = 0u;
    for (;;) {
        sum = 0u; cnt = 0u; mine = 0u;
#pragma unroll
        for (unsigned j = 0; j < 16; ++j) { const unsigned c = xb_ld(&bar[XB_XCNT(j)]); sum += c; cnt += (c > 0u) ? 1u : 0u; mine = (j == x) ? c : mine; }
        if (sum == G) break;
        __builtin_amdgcn_s_sleep(1);
        if ((++sp & 255u) == 0u) { if (xb_ld(&bar[XB_TMO])) break; if (sp > XB_SPIN_CAP) { atomicAdd(&bar[XB_TMO], 1u); break; } }
    }
    nloc = mine > 0u ? mine : 1u; nx = cnt > 0u ? cnt : 1u;
}
DI void xcd_barrier(const XcdBarrier& b) {
    asm volatile("s_waitcnt vmcnt(0)" ::: "memory");
    __syncthreads();
    if (threadIdx.x == 0) {
        unsigned* bar = b.bar;
        __builtin_amdgcn_s_waitcnt(0);
        unsigned nloc = b.st[0], nx = b.st[1];
        if (nloc == 0u) { xcd_barrier_complete(bar, b.x, nloc, nx); b.st[0] = nloc; b.st[1] = nx; }
        const unsigned old = xb_add(&bar[XB_XSUB(b.x)], 1u);
        const unsigned gen = old / nloc;
        if (old + 1u == (gen + 1u) * nloc) {
            __builtin_amdgcn_fence(__ATOMIC_RELEASE, "agent");
            asm volatile("s_waitcnt vmcnt(0)" ::: "memory");
            const unsigned og = xb_add(&bar[XB_TOP], 1u);
            const unsigned tg = og / nx;
            if (og + 1u == (tg + 1u) * nx) xb_add(&bar[XB_TOPGEN], 1u);
            else XB_SPIN(xb_ld(&bar[XB_TOPGEN]) == tg, bar);
            __builtin_amdgcn_fence(__ATOMIC_ACQUIRE, "agent");
            xb_add(&bar[XB_XGEN(b.x)], 1u);
            asm volatile("s_waitcnt vmcnt(0)" ::: "memory");
        } else {
            XB_SPIN(xb_ld(&bar[XB_XGEN(b.x)]) == gen, bar);
            __builtin_amdgcn_fence(__ATOMIC_ACQUIRE, "agent");
            asm volatile("s_waitcnt vmcnt(0)" ::: "memory");
        }
    }
    __syncthreads();
}
constexpr size_t WS_BAR = 4096;
constexpr int NPHASE = 18;
__global__ void __launch_bounds__(NTHREADS, 2) fwd_kernel(Params p_unused) {
#if defined(__HIP_DEVICE_COMPILE__)
    extern __shared__ __attribute__((aligned(16))) unsigned char lds_raw[];
    LAS unsigned char* lds = (LAS unsigned char*)lds_raw;
    cg::grid_group grid = cg::this_grid();
    PP pk = (PP)__builtin_amdgcn_kernarg_segment_ptr();
    const int ph_lo = pk->ph_lo, ph_hi = pk->ph_hi;
    volatile LAS unsigned* xst = (volatile LAS unsigned*)(lds + 131072 + 4096);
    if (threadIdx.x == 0) { xst[0] = 0u; xst[1] = 0u; }
    __syncthreads();
    const XcdBarrier xbar = xcd_barrier_post((unsigned*)(pk->ws + WS_BAR), xst);
    for (int ph = ph_lo; ph < ph_hi; ++ph) {
        if (ph > ph_lo) { if (ph == ph_lo + 1) grid.sync(); else xcd_barrier(xbar); }
        PP pp = pk; asm volatile("" : "+s"(pp));
        if (ph == 0) { const Params p = *pp; phase0(p, lds); continue; }
        if (ph == NPHASE - 1) { phase_final(pp->out, (const bf16_t*)(pp->ws + WS_HDN), pp->final_g, (const float*)(pp->ws + WS_SSQXP) + (size_t)2 * T * 16); continue; }
        const int l = (ph - 1) >> 3, s = (ph - 1) & 7;
        if (s == 0) {
            const Params p = *pp; unsigned char* ws = p.ws;
            phase_convert(p, l, lds);
            __syncthreads();
            phase_bias(p, l, lds);
            if (l == 0) phase_pre(p.x, p.norm1_g, (const float*)(ws + WS_MOD), (bf16_t*)(ws + WS_HDN), (float*)(ws + WS_SSQXP));
        } else if (s == 3) {
            unsigned char* ws = pp->ws;
            attn_phase(ws, lds, (unsigned*)(ws + WS_CTR) + l, ph_hi == 12345);
        } else {
            unsigned char* ws = pp->ws;
            pg8::Sched S; S.G = gridDim.x; S.c = blockIdx.x; S.ws = (const char*)ws;
            pg8::Epi E; E.pp = pk; E.l = l;
            S.mode = s == 1 ? pg8::M_PROJ : (s == 2 ? pg8::M_UP : (s == 4 ? pg8::M_MERGE : (s == 5 ? pg8::M_OUT : (s == 6 ? pg8::M_FF1 : pg8::M_FF2))));
            pg8::gemm_phase(lds, S, E);
            if (s == 2) phase_kmean(ws, lds);
        }
    }
#endif
}

extern "C" void kernel_launch(void* const* d_in, const int* in_sizes, int n_in, void* d_out, int out_size, void* d_ws, size_t ws_size, hipStream_t stream) {
    static int grid = 0;
    if (grid == 0) {
        if (n_in != 19 || in_sizes[0] != T * DM || out_size != T * DM || ws_size < WS_END) {
            fprintf(stderr, "kernel_launch: unexpected shapes/workspace (n_in %d, in0 %d, out %d, ws %zu; need ws >= %zu); nothing launched\n", n_in, n_in > 0 ? in_sizes[0] : -1, out_size, ws_size, (size_t)WS_END);
            grid = -1; return; }
        int dev = 0, cus = 0, per_cu = 0;
        hipGetDevice(&dev); hipDeviceGetAttribute(&cus, hipDeviceAttributeMultiprocessorCount, dev);
        if (hipFuncSetAttribute((const void*)fwd_kernel, hipFuncAttributeMaxDynamicSharedMemorySize, LDS_BYTES) != hipSuccess) { fprintf(stderr, "kernel_launch: hipFuncSetAttribute failed\n"); grid = -1; return; }
        if (hipOccupancyMaxActiveBlocksPerMultiprocessor(&per_cu, (const void*)fwd_kernel, NTHREADS, LDS_BYTES) != hipSuccess || per_cu < 1) { fprintf(stderr, "kernel_launch: occupancy query says %d blocks/CU\n", per_cu); per_cu = 1; }
        (void)hipGetLastError();
        grid = cus * per_cu; if (grid > 256) grid = 256; if (grid % 8) grid -= grid % 8;
    }
    if (grid <= 0) return;
    Params p{};
    p.x = (const float*)d_in[0]; p.c = (const float*)d_in[1]; p.pos = (const int*)d_in[2]; p.w_ada = (const float*)d_in[3]; p.b_ada = (const float*)d_in[4];
    p.norm1_g = (const float*)d_in[5]; p.norm2_g = (const float*)d_in[6]; p.w_in = (const float*)d_in[7]; p.q_norm_g = (const float*)d_in[8]; p.w_uq = (const float*)d_in[9];
    p.kv_norm_g = (const float*)d_in[10]; p.w_ukv = (const float*)d_in[11]; p.w_o_mla = (const float*)d_in[12]; p.w_o_sb = (const float*)d_in[13]; p.w_o_moba = (const float*)d_in[14];
    p.w_out = (const float*)d_in[15]; p.w_ff1 = (const float*)d_in[16]; p.w_ff2 = (const float*)d_in[17]; p.final_g = (const float*)d_in[18];
    p.out = (float*)d_out; p.ws = (unsigned char*)d_ws; p.ph_lo = 0; p.ph_hi = NPHASE;
    (void)hipMemsetAsync((char*)d_ws + WS_BAR, 0, 16384, stream);
    void* args[] = {&p};
    hipError_t e = hipLaunchCooperativeKernel((const void*)fwd_kernel, dim3(grid), dim3(NTHREADS), args, LDS_BYTES, stream);
    if (e != hipSuccess) fprintf(stderr, "kernel_launch: cooperative launch failed: %s (grid %d)\n", hipGetErrorString(e), grid);
}
```

```cpp
#include <hip/hip_runtime.h>
#include <hip/hip_cooperative_groups.h>
#include <cstdio>
#include <cstdint>
namespace cg = cooperative_groups;

#define LAS __attribute__((address_space(3)))
#define DI __device__ __forceinline__
typedef unsigned short bf16_t;
typedef short bf16x8 __attribute__((ext_vector_type(8)));
typedef short s16x4 __attribute__((ext_vector_type(4)));
typedef float f32x4 __attribute__((ext_vector_type(4)));
typedef float f32x2 __attribute__((ext_vector_type(2)));
typedef float f32x16 __attribute__((ext_vector_type(16)));
typedef unsigned u32x4 __attribute__((ext_vector_type(4)));
typedef unsigned u32x2 __attribute__((ext_vector_type(2)));
typedef __bf16 bf16x2_t __attribute__((ext_vector_type(2)));

constexpr int T = 32768, SEQ = 4096, NB = 8, DM = 1024, DFF = 4096, DEPTH = 2;
constexpr float EPS = 1e-6f;
constexpr float LOG2E = 1.4426950408889634f;
constexpr float C_MLA = 0.10206207261596577f * LOG2E;
constexpr float C_MB = 0.125f * LOG2E;
constexpr int NWIN = 7424;

constexpr size_t MiB = 1u << 20;
constexpr size_t WS_CTR = 0;
constexpr size_t WS_MOD = 1 * MiB;
constexpr size_t WS_SSQQ = 2 * MiB;
constexpr size_t WS_SSQKV = 2 * MiB + 256 * 1024;
constexpr size_t WS_SSQX = 2 * MiB + 512 * 1024;
constexpr size_t WS_KMEAN = 3 * MiB;
constexpr size_t WS_ROPEM = 4 * MiB;
constexpr size_t WS_ROPEB = 8 * MiB;
constexpr size_t WS_BIAS1 = 10 * MiB;
constexpr size_t WS_BIAS2 = 11 * MiB;
constexpr size_t WS_W = 16 * MiB;
constexpr size_t W_IN = WS_W, W_UQ = WS_W + 15 * MiB, W_UKV = WS_W + 16 * MiB + 512 * 1024, W_O = WS_W + 17 * MiB, W_OUT = WS_W + 20 * MiB, W_FF1 = WS_W + 22 * MiB, W_FF2 = WS_W + 30 * MiB;
constexpr size_t WS_HDN = 56 * MiB;
constexpr size_t WS_QLAT = 120 * MiB;
constexpr size_t WS_CKV = 168 * MiB;
constexpr size_t WS_OMLA = 120 * MiB;
constexpr size_t WS_KPE = 184 * MiB;
constexpr size_t WS_SB = 186 * MiB;
constexpr size_t WS_MB = 282 * MiB;
constexpr size_t WS_QMLA = 378 * MiB;
constexpr size_t WS_STASH = 378 * MiB;
constexpr size_t WS_KVMLA = 426 * MiB;
constexpr size_t WS_MERGED = 426 * MiB;
constexpr size_t WS_H = 186 * MiB;
constexpr size_t WS_SSQXP = 490 * MiB;
constexpr size_t WS_SSQQP = 498 * MiB;
constexpr size_t WS_SSQKVP = 500 * MiB;
constexpr size_t WS_END = 502 * MiB;

constexpr int LDS_BYTES = 147456;
constexpr int NTHREADS = 512;

DI int tid_opaque() { int t = threadIdx.x; asm volatile("" : "+v"(t)); return t; }
DI unsigned pk2(float lo, float hi) { f32x2 v = {lo, hi}; bf16x2_t b = __builtin_convertvector(v, bf16x2_t); return __builtin_bit_cast(unsigned, b); }
DI float bf_lo(unsigned u) { return __uint_as_float(u << 16); }
DI float bf_hi(unsigned u) { return __uint_as_float(u & 0xffff0000u); }
DI u32x2 pk4(f32x4 v) { u32x2 r; r.x = pk2(v[0], v[1]); r.y = pk2(v[2], v[3]); return r; }
DI float wave_sum(float v) {
#pragma unroll
    for (int o = 32; o >= 1; o >>= 1) v += __shfl_xor(v, o);
    return v;
}
DI float fast_exp2(float x) { return __builtin_amdgcn_exp2f(x); }
DI float fast_exp(float x) { return __builtin_amdgcn_exp2f(x * LOG2E); }
DI float fast_log(float x) { return __builtin_amdgcn_logf(x) * 0.6931471805599453f; }
DI float sigmoidf_(float x) { return __builtin_amdgcn_rcpf(1.f + fast_exp(-x)); }

DI float sum16(const float* p) { const f32x4 a = *(const f32x4*)p, b = *(const f32x4*)(p + 4), c = *(const f32x4*)(p + 8), d = *(const f32x4*)(p + 12); return (((a[0] + a[1]) + (a[2] + a[3])) + ((b[0] + b[1]) + (b[2] + b[3]))) + (((c[0] + c[1]) + (c[2] + c[3])) + ((d[0] + d[1]) + (d[2] + d[3]))); }
DI float sum12(const float* p) { const f32x4 a = *(const f32x4*)p, b = *(const f32x4*)(p + 4), c = *(const f32x4*)(p + 8); return (((a[0] + a[1]) + (a[2] + a[3])) + ((b[0] + b[1]) + (b[2] + b[3]))) + ((c[0] + c[1]) + (c[2] + c[3])); }
DI float sum4(const float* p) { const f32x4 a = *(const f32x4*)p; return (a[0] + a[1]) + (a[2] + a[3]); }

struct Params {
    const float* x; const float* c; const int* pos; const float* w_ada; const float* b_ada; const float* norm1_g; const float* norm2_g;
    const float* w_in; const float* q_norm_g; const float* w_uq; const float* kv_norm_g; const float* w_ukv;
    const float* w_o_mla; const float* w_o_sb; const float* w_o_moba; const float* w_out; const float* w_ff1; const float* w_ff2; const float* final_g;
    float* out; unsigned char* ws;
    int ph_lo, ph_hi;
};

typedef const Params __attribute__((address_space(4)))* PP;

namespace pg8 {
constexpr int BM = 256, BK = 64, HALF = 128, HTB = HALF * BK * 2, STAGE_BYTES = 8 * HTB, NXCD = 8, WGM = 8;
DI int lds_byte(int r, int c) { const int st = (r >> 4) * 2 + (c >> 5), rr = r & 15, cc = c & 31, ob = rr * 64 + cc * 2; return st * 1024 + (ob ^ (((ob >> 9) & 1) << 5)); }
DI int perm32(int rho) { const int n = rho >> 4, i = rho & 15; return 8 * (i >> 2) + 4 * n + (i & 3); }
DI void stage_rc(int b, int& R, int& C) { const int st = b / 1024, sb = b % 1024, swz = sb ^ (((sb >> 9) & 1) << 5); R = (st >> 1) * 16 + swz / 64; C = (st & 1) * 32 + (swz % 64) / 2; }

enum { K_QLAT = 0, K_CKV, K_KPE, K_SB, K_MB, K_UQ, K_UKV, K_GATE, K_BR0, K_BR1, K_BR2, K_OUT, K_FF1, K_FF2 };
enum { M_PROJ = 0, M_UP, M_MERGE, M_OUT, M_FF1, M_FF2 };

struct Unit { const char* A; const char* B; int lda, ldb; int nt, kind; int pm, pn; };

DI void tile_map(int L, int nM, int nN, int& pm, int& pn) {
    const int nwg = nM * nN; int wgid = L;
    { const int q = nwg / NXCD, r = nwg % NXCD, xcd = wgid % NXCD, off = wgid / NXCD; wgid = (xcd < r ? xcd * (q + 1) : r * (q + 1) + (xcd - r) * q) + off; }
    const int nig = WGM * nN, gid = wgid / nig, fm = gid * WGM, gsz = (nM - fm) < WGM ? (nM - fm) : WGM;
    pm = __builtin_amdgcn_readfirstlane(fm + ((wgid % nig) % gsz)); pn = __builtin_amdgcn_readfirstlane((wgid % nig) / gsz);
}

struct Sched {
    int mode, G, c; const char* ws;
    DI bool next(int i, Unit& u) const {
        const int nM = T / BM;
        if (mode == M_PROJ) {
            const long L = (long)i * G + c; if (L >= nM * 17) return false;
            tile_map((int)L, nM, 17, u.pm, u.pn);
            u.lda = 2048; u.ldb = 2048; u.nt = 16;
            u.A = ws + WS_HDN + (size_t)u.pm * BM * 2048; u.B = ws + W_IN + (size_t)u.pn * BM * 2048;
            u.kind = u.pn < 3 ? K_QLAT : (u.pn == 3 ? K_CKV : (u.pn == 4 ? K_KPE : (u.pn < 11 ? K_SB : K_MB)));
            return true;
        } else if (mode == M_UP) {
            const long L = (long)i * G + c; if (L >= nM * 7) return false;
            if (L < nM * 3) { tile_map((int)L, nM, 3, u.pm, u.pn); u.lda = 1536; u.ldb = 1536; u.nt = 12; u.kind = K_UQ;
                u.A = ws + WS_QLAT + (size_t)u.pm * BM * 1536; u.B = ws + W_UQ + (size_t)u.pn * BM * 1536; }
            else { tile_map((int)L - nM * 3, nM, 4, u.pm, u.pn); u.lda = 512; u.ldb = 512; u.nt = 4; u.kind = K_UKV;
                u.A = ws + WS_CKV + (size_t)u.pm * BM * 512; u.B = ws + W_UKV + (size_t)u.pn * BM * 512; }
            return true;
        } else if (mode == M_MERGE) {
            const int tl = i / 6, sub = i - tl * 6, br = sub >> 1;
            const long L = (long)tl * G + c; if (L >= nM * 4) return false;
            tile_map((int)L, nM, 4, u.pm, u.pn);
            if ((sub & 1) == 0) { u.lda = 2048; u.ldb = 2048; u.nt = 16; u.kind = K_GATE;
                u.A = ws + WS_HDN + (size_t)u.pm * BM * 2048; u.B = ws + W_IN + (size_t)(4352 + br * 1024 + u.pn * BM) * 2048; }
            else { u.ldb = 1024; u.nt = 8; u.kind = K_BR0 + br;
                u.lda = br == 0 ? 1024 : 3072;
                u.A = ws + (br == 0 ? WS_OMLA : (br == 1 ? WS_SB : WS_MB)) + (size_t)u.pm * BM * u.lda;
                u.B = ws + W_O + (size_t)(br * 1024 + u.pn * BM) * 1024; }
            return true;
        } else if (mode == M_OUT) {
            const long L = (long)i * G + c; if (L >= nM * 4) return false;
            tile_map((int)L, nM, 4, u.pm, u.pn); u.lda = 2048; u.ldb = 2048; u.nt = 16; u.kind = K_OUT;
            u.A = ws + WS_MERGED + (size_t)u.pm * BM * 2048; u.B = ws + W_OUT + (size_t)u.pn * BM * 2048; return true;
        } else if (mode == M_FF1) {
            const long L = (long)i * G + c; if (L >= nM * 16) return false;
            tile_map((int)L, nM, 16, u.pm, u.pn); u.lda = 2048; u.ldb = 2048; u.nt = 16; u.kind = K_FF1;
            u.A = ws + WS_HDN + (size_t)u.pm * BM * 2048; u.B = ws + W_FF1 + (size_t)u.pn * BM * 2048; return true;
        } else {
            const long L = (long)i * G + c; if (L >= nM * 4) return false;
            tile_map((int)L, nM, 4, u.pm, u.pn); u.lda = 8192; u.ldb = 8192; u.nt = 64; u.kind = K_FF2;
            u.A = ws + WS_H + (size_t)u.pm * BM * 8192; u.B = ws + W_FF2 + (size_t)u.pn * BM * 8192; return true;
        }
    }
};

struct Epi {
    PP pp; int l;
    template <int NS> DI void rowstat(float (&rs)[2][4], const float* parts, float inv_n, float mul, int rowbase_wave, LAS float* buf, int lane, int fr) const {
#pragma unroll
        for (int h = 0; h < 2; ++h) { const float* pp = parts + (size_t)(rowbase_wave + h * 128 + lane) * (NS == 4 ? 4 : 16);
            const float sm = NS == 16 ? sum16(pp) : (NS == 12 ? sum12(pp) : sum4(pp)); buf[h * 64 + lane] = __builtin_amdgcn_rsqf(sm * inv_n + EPS) * mul; }
#pragma unroll
        for (int ai = 0; ai < 2; ++ai)
#pragma unroll
            for (int m = 0; m < 4; ++m) rs[ai][m] = buf[ai * 64 + m * 16 + fr];
    }
    DI void operator()(const f32x4 (&acc)[2][2][4][2], const Unit& u, int wr, int wc, int fr, int fq, int tid, LAS unsigned char* lds) const {
        asm volatile("" : "+v"(fr), "+v"(fq), "+v"(tid));
        PP q = pp; asm volatile("" : "+s"(q));
        unsigned char* ws = q->ws; float* out = q->out; const float* xin = l == 0 ? q->x : q->out;
        const float* mod = (const float*)(ws + WS_MOD) + (size_t)l * 8 * 6144;
        float* ssqx = (float*)(ws + WS_SSQXP);
        const float* ssq1 = ssqx + (size_t)l * T * 16; float* ssq2 = ssqx + (size_t)3 * T * 16; float* ssqn = ssqx + (size_t)(l + 1) * T * 16;
        const float* bias1 = (const float*)(ws + WS_BIAS1) + (size_t)l * 8 * NWIN; const float* bias2 = (const float*)(ws + WS_BIAS2) + (size_t)l * 8 * 4096;
        const float* g2 = q->norm2_g + l * 1024; const float* g1n = q->norm1_g + ((l + 1) % DEPTH) * 1024; const float* modn = (const float*)(ws + WS_MOD) + (size_t)((l + 1) % DEPTH) * 8 * 6144;
        const int rbw = u.pm * BM + wr * 64, bidx = (u.pm * BM) >> 12;
#define EPI_CASE_BEGIN asm volatile("" : "+v"(fr), "+v"(fq), "+v"(tid)); const int row0 = u.pm * BM + wr * 64 + fr, lc0 = wc * 32 + fq * 8, lane = tid & 63; LAS float* rsbuf = (LAS float*)(lds + 131072) + (tid >> 6) * 128; float rs[2][4]; (void)row0; (void)lc0; (void)lane; (void)rsbuf; (void)rs;
#define PK8(v0, v1) ((u32x4){pk2((v0)[0], (v0)[1]), pk2((v0)[2], (v0)[3]), pk2((v1)[0], (v1)[1]), pk2((v1)[2], (v1)[3])})
        switch (u.kind) {
        case K_QLAT: case K_CKV: { EPI_CASE_BEGIN
            const bool isq = u.kind == K_QLAT;
            bf16_t* dst = (bf16_t*)(ws + (isq ? WS_QLAT : WS_CKV)); const int ld = isq ? 768 : 256; const int cb = isq ? u.pn * 256 : 0;
            float* ssq = (float*)(ws + (isq ? WS_SSQQP : WS_SSQKVP));
            rowstat<16>(rs, ssq1, 1.f / 1024.f, 1.f, rbw, rsbuf, lane, fr);
            f32x4 bv[2][2];
#pragma unroll
            for (int bj = 0; bj < 2; ++bj)
#pragma unroll
                for (int n = 0; n < 2; ++n) bv[bj][n] = *(const f32x4*)(bias1 + bidx * NWIN + u.pn * 256 + lc0 + bj * 128 + n * 4);
#pragma unroll
            for (int ai = 0; ai < 2; ++ai)
#pragma unroll
                for (int m = 0; m < 4; ++m) { const int row = row0 + ai * 128 + m * 16; float s = 0.f;
#pragma unroll
                    for (int bj = 0; bj < 2; ++bj) { const f32x4 v0 = acc[ai][bj][m][0] * rs[ai][m] + bv[bj][0], v1 = acc[ai][bj][m][1] * rs[ai][m] + bv[bj][1];
                        s += ((v0[0] * v0[0] + v0[1] * v0[1]) + (v0[2] * v0[2] + v0[3] * v0[3])) + ((v1[0] * v1[0] + v1[1] * v1[1]) + (v1[2] * v1[2] + v1[3] * v1[3]));
                        *(u32x4*)(dst + (size_t)row * ld + cb + lc0 + bj * 128) = PK8(v0, v1); }
                    s += __shfl_xor(s, 16); s += __shfl_xor(s, 32);
                    if (fq == 0) { if (isq) ssq[(size_t)row * 16 + u.pn * 4 + wc] = s; else ssq[(size_t)row * 4 + wc] = s; } }
        } break;
        case K_KPE: { EPI_CASE_BEGIN
            if (wc == 0) {
                bf16_t* dst = (bf16_t*)(ws + WS_KPE); const float* rt = (const float*)(ws + WS_ROPEM);
                rowstat<16>(rs, ssq1, 1.f / 1024.f, 1.f, rbw, rsbuf, lane, fr);
                const f32x4 b0 = *(const f32x4*)(bias1 + bidx * NWIN + 1024 + fq * 8), b1 = *(const f32x4*)(bias1 + bidx * NWIN + 1024 + fq * 8 + 4);
#pragma unroll
                for (int ai = 0; ai < 2; ++ai)
#pragma unroll
                    for (int m = 0; m < 4; ++m) { const int row = row0 + ai * 128 + m * 16;
                        const float* rr = rt + (size_t)row * 32 + (fq & 1) * 8;
                        const f32x4 cs0 = *(const f32x4*)rr, cs1 = *(const f32x4*)(rr + 4), sn0 = *(const f32x4*)(rr + 16), sn1 = *(const f32x4*)(rr + 20);
                        const f32x4 v0 = acc[ai][0][m][0] * rs[ai][m] + b0, v1 = acc[ai][0][m][1] * rs[ai][m] + b1; f32x4 p0, p1;
#pragma unroll
                        for (int e = 0; e < 4; ++e) { p0[e] = __shfl_xor(v0[e], 32); p1[e] = __shfl_xor(v1[e], 32); }
                        const f32x4 o0 = fq < 2 ? (v0 * cs0 - p0 * sn0) : (p0 * sn0 + v0 * cs0), o1 = fq < 2 ? (v1 * cs1 - p1 * sn1) : (p1 * sn1 + v1 * cs1);
                        *(u32x4*)(dst + (size_t)row * 32 + fq * 8) = PK8(o0, o1); }
            }
        } break;
        case K_SB: case K_MB: { EPI_CASE_BEGIN
            const bool ismb = u.kind == K_MB;
            const int t = u.pn - (ismb ? 11 : 5); bf16_t* dst = (bf16_t*)(ws + (ismb ? WS_MB : WS_SB)); const float sc = t < 2 ? (ismb ? C_MB : 0.125f) : 1.f; const float* rt = (const float*)(ws + WS_ROPEB);
            const bool rope = ismb && (t < 4) && ((wc & 1) == 0);
            rowstat<16>(rs, ssq1, 1.f / 1024.f, 1.f, rbw, rsbuf, lane, fr);
            f32x4 bv[2][2];
#pragma unroll
            for (int bj = 0; bj < 2; ++bj)
#pragma unroll
                for (int n = 0; n < 2; ++n) bv[bj][n] = *(const f32x4*)(bias1 + bidx * NWIN + u.pn * 256 + lc0 + bj * 128 + n * 4);
#pragma unroll
            for (int ai = 0; ai < 2; ++ai)
#pragma unroll
                for (int m = 0; m < 4; ++m) { const int row = row0 + ai * 128 + m * 16;
                    f32x4 cs0 = {1.f, 1.f, 1.f, 1.f}, cs1 = cs0, sn0 = {0.f, 0.f, 0.f, 0.f}, sn1 = sn0;
                    if (rope) { const float* rr = rt + (size_t)row * 16; cs0 = *(const f32x4*)rr; cs1 = *(const f32x4*)(rr + 4); sn0 = *(const f32x4*)(rr + 8); sn1 = *(const f32x4*)(rr + 12); }
#pragma unroll
                    for (int bj = 0; bj < 2; ++bj) { f32x4 v0 = acc[ai][bj][m][0] * rs[ai][m] + bv[bj][0], v1 = acc[ai][bj][m][1] * rs[ai][m] + bv[bj][1];
                        if (rope) { f32x4 p0, p1;
#pragma unroll
                            for (int e = 0; e < 4; ++e) { p0[e] = __shfl_xor(v0[e], 16); p1[e] = __shfl_xor(v1[e], 16); }
                            if (fq == 0) { v0 = v0 * cs0 - p0 * sn0; v1 = v1 * cs1 - p1 * sn1; } else if (fq == 1) { v0 = p0 * sn0 + v0 * cs0; v1 = p1 * sn1 + v1 * cs1; } }
                        v0 = v0 * sc; v1 = v1 * sc;
                        *(u32x4*)(dst + (size_t)row * 1536 + t * 256 + lc0 + bj * 128) = PK8(v0, v1); } }
        } break;
        case K_UQ: { EPI_CASE_BEGIN
            bf16_t* dst = (bf16_t*)(ws + WS_QMLA); const float* rt = (const float*)(ws + WS_ROPEM);
            rowstat<12>(rs, (const float*)(ws + WS_SSQQP), 1.f / 768.f, C_MLA, rbw, rsbuf, lane, fr);
#pragma unroll
            for (int ai = 0; ai < 2; ++ai)
#pragma unroll
                for (int m = 0; m < 4; ++m) { const int row = row0 + ai * 128 + m * 16;
                    const float* rr = rt + (size_t)row * 32 + (fq & 1) * 8;
                    const f32x4 cs0 = *(const f32x4*)rr, cs1 = *(const f32x4*)(rr + 4), sn0 = *(const f32x4*)(rr + 16), sn1 = *(const f32x4*)(rr + 20);
#pragma unroll
                    for (int bj = 0; bj < 2; ++bj) { const int gc = u.pn * 256 + bj * 128 + wc * 32; const bool pe = ((gc >> 5) % 3) == 2;
                        f32x4 v0 = acc[ai][bj][m][0] * rs[ai][m], v1 = acc[ai][bj][m][1] * rs[ai][m];
                        if (pe) { f32x4 p0, p1;
#pragma unroll
                            for (int e = 0; e < 4; ++e) { p0[e] = __shfl_xor(v0[e], 32); p1[e] = __shfl_xor(v1[e], 32); }
                            if (fq < 2) { v0 = v0 * cs0 - p0 * sn0; v1 = v1 * cs1 - p1 * sn1; } else { v0 = p0 * sn0 + v0 * cs0; v1 = p1 * sn1 + v1 * cs1; } }
                        *(u32x4*)(dst + (size_t)row * 768 + gc + fq * 8) = PK8(v0, v1); } }
        } break;
        case K_UKV: { EPI_CASE_BEGIN
            bf16_t* dst = (bf16_t*)(ws + WS_KVMLA);
            rowstat<4>(rs, (const float*)(ws + WS_SSQKVP), 1.f / 256.f, 1.f, rbw, rsbuf, lane, fr);
#pragma unroll
            for (int ai = 0; ai < 2; ++ai)
#pragma unroll
                for (int m = 0; m < 4; ++m) { const int row = row0 + ai * 128 + m * 16;
#pragma unroll
                    for (int bj = 0; bj < 2; ++bj) { const f32x4 v0 = acc[ai][bj][m][0] * rs[ai][m], v1 = acc[ai][bj][m][1] * rs[ai][m];
                        *(u32x4*)(dst + (size_t)row * 1024 + u.pn * 256 + lc0 + bj * 128) = PK8(v0, v1); } }
        } break;
        case K_GATE: { EPI_CASE_BEGIN
            u32x4* st = (u32x4*)(ws + WS_STASH + (size_t)blockIdx.x * 131072) + tid;
            const int gcol = (int)((u.B - (const char*)(ws + W_IN)) >> 11) + lc0;
            rowstat<16>(rs, ssq1, 1.f / 1024.f, 1.f, rbw, rsbuf, lane, fr);
            f32x4 bv[2][2];
#pragma unroll
            for (int bj = 0; bj < 2; ++bj)
#pragma unroll
                for (int n = 0; n < 2; ++n) bv[bj][n] = *(const f32x4*)(bias1 + bidx * NWIN + gcol + bj * 128 + n * 4);
#pragma unroll
            for (int ai = 0; ai < 2; ++ai)
#pragma unroll
                for (int m = 0; m < 4; ++m)
#pragma unroll
                    for (int bj = 0; bj < 2; ++bj) { f32x4 g0, g1;
                        const f32x4 a0 = acc[ai][bj][m][0] * rs[ai][m] + bv[bj][0], a1 = acc[ai][bj][m][1] * rs[ai][m] + bv[bj][1];
#pragma unroll
                        for (int e = 0; e < 4; ++e) { g0[e] = sigmoidf_(a0[e]); g1[e] = sigmoidf_(a1[e]); }
                        st[((ai * 4 + m) * 2 + bj) * 512] = PK8(g0, g1); }
        } break;
        case K_BR0: case K_BR1: case K_BR2: { EPI_CASE_BEGIN
            const u32x4* st = (const u32x4*)(ws + WS_STASH + (size_t)blockIdx.x * 131072) + tid; bf16_t* dst = (bf16_t*)(ws + WS_MERGED);
            const bool first = u.kind == K_BR0;
#pragma unroll
            for (int ai = 0; ai < 2; ++ai)
#pragma unroll
                for (int m = 0; m < 4; ++m) { const int row = row0 + ai * 128 + m * 16;
#pragma unroll
                    for (int bj = 0; bj < 2; ++bj) { const u32x4 g = st[((ai * 4 + m) * 2 + bj) * 512];
                        u32x4* d = (u32x4*)(dst + (size_t)row * 1024 + u.pn * 256 + lc0 + bj * 128);
                        const f32x4 a0 = acc[ai][bj][m][0], a1 = acc[ai][bj][m][1];
                        f32x4 r0 = {bf_lo(g.x) * a0[0], bf_hi(g.x) * a0[1], bf_lo(g.y) * a0[2], bf_hi(g.y) * a0[3]}, r1 = {bf_lo(g.z) * a1[0], bf_hi(g.z) * a1[1], bf_lo(g.w) * a1[2], bf_hi(g.w) * a1[3]};
                        if (!first) { const u32x4 o = *d; r0[0] += bf_lo(o.x); r0[1] += bf_hi(o.x); r0[2] += bf_lo(o.y); r0[3] += bf_hi(o.y); r1[0] += bf_lo(o.z); r1[1] += bf_hi(o.z); r1[2] += bf_lo(o.w); r1[3] += bf_hi(o.w); }
                        *d = PK8(r0, r1); } }
        } break;
        case K_OUT: case K_FF2: { EPI_CASE_BEGIN
            const bool isout = u.kind == K_OUT;
            const int goff = isout ? 2048 : 5120; const float* src = isout ? xin : out;
            const float* gn = isout ? g2 : g1n; const float* mn = isout ? mod + 4096 : modn + 1024;
            float* ssqo = isout ? ssq2 : ssqn; bf16_t* hd = (bf16_t*)(ws + WS_HDN);
            const bool lastff2 = !isout && (l + 1 == DEPTH);
            f32x4 gv[2][2], fac[2][2];
#pragma unroll
            for (int bj = 0; bj < 2; ++bj)
#pragma unroll
                for (int n = 0; n < 2; ++n) { const int col = u.pn * 256 + lc0 + bj * 128 + n * 4;
                    gv[bj][n] = *(const f32x4*)(mod + bidx * 6144 + goff + col);
                    fac[bj][n] = lastff2 ? (f32x4){1.f, 1.f, 1.f, 1.f} : *(const f32x4*)(gn + col) * (*(const f32x4*)(mn + bidx * 6144 + col) + 1.f); }
            bf16_t* xb = (bf16_t*)out;
            const bool f32res = isout && l == 0;
#pragma unroll
            for (int ai = 0; ai < 2; ++ai)
#pragma unroll
                for (int m = 0; m < 4; ++m) { __builtin_amdgcn_sched_barrier(0);
                    const size_t ro = (size_t)(row0 + ai * 128 + m * 16) * 1024 + u.pn * 256 + lc0; float sv = 0.f;
#pragma unroll
                    for (int bj = 0; bj < 2; ++bj) { const int co = bj * 128;
                        f32x4 r0, r1;
                        if (f32res) { r0 = *(const f32x4*)(src + ro + co); r1 = *(const f32x4*)(src + ro + co + 4); }
                        else { const u32x4 rb = *(const u32x4*)(xb + ro + co); r0 = (f32x4){bf_lo(rb.x), bf_hi(rb.x), bf_lo(rb.y), bf_hi(rb.y)}; r1 = (f32x4){bf_lo(rb.z), bf_hi(rb.z), bf_lo(rb.w), bf_hi(rb.w)}; }
                        const f32x4 x0 = r0 + gv[bj][0] * acc[ai][bj][m][0], x1 = r1 + gv[bj][1] * acc[ai][bj][m][1];
                        if (!lastff2) *(u32x4*)(xb + ro + co) = PK8(x0, x1);
                        sv += ((x0[0] * x0[0] + x0[1] * x0[1]) + (x0[2] * x0[2] + x0[3] * x0[3])) + ((x1[0] * x1[0] + x1[1] * x1[1]) + (x1[2] * x1[2] + x1[3] * x1[3]));
                        const f32x4 h0 = x0 * fac[bj][0], h1 = x1 * fac[bj][1];
                        *(u32x4*)(hd + ro + co) = PK8(h0, h1); }
                    sv += __shfl_xor(sv, 16); sv += __shfl_xor(sv, 32);
                    if (fq == 0) ssqo[(size_t)(row0 + ai * 128 + m * 16) * 16 + u.pn * 4 + wc] = sv; }
        } break;
        case K_FF1: { EPI_CASE_BEGIN
            bf16_t* dst = (bf16_t*)(ws + WS_H);
            rowstat<16>(rs, ssq2, 1.f / 1024.f, 1.f, rbw, rsbuf, lane, fr);
            f32x4 bv[2][2];
#pragma unroll
            for (int bj = 0; bj < 2; ++bj)
#pragma unroll
                for (int n = 0; n < 2; ++n) bv[bj][n] = *(const f32x4*)(bias2 + bidx * 4096 + u.pn * 256 + lc0 + bj * 128 + n * 4);
#pragma unroll
            for (int ai = 0; ai < 2; ++ai)
#pragma unroll
                for (int m = 0; m < 4; ++m) { const int row = row0 + ai * 128 + m * 16;
#pragma unroll
                    for (int bj = 0; bj < 2; ++bj) { f32x4 v0 = acc[ai][bj][m][0] * rs[ai][m] + bv[bj][0], v1 = acc[ai][bj][m][1] * rs[ai][m] + bv[bj][1];
#pragma unroll
                        for (int e = 0; e < 4; ++e) { const float t0 = fmaxf(v0[e], 0.f), t1 = fmaxf(v1[e], 0.f); v0[e] = t0 * t0; v1[e] = t1 * t1; }
                        *(u32x4*)(dst + (size_t)row * 4096 + u.pn * 256 + lc0 + bj * 128) = PK8(v0, v1); } }
        } break;
        }
    }
};

DI void gemm_phase(LAS unsigned char* lds, const Sched& S_, const Epi& E) {
    Sched S = S_; asm volatile("" : "+s"(S.c));
    const int tid = tid_opaque(), wid = __builtin_amdgcn_readfirstlane(tid >> 6), lane = tid & 63, wr = wid >> 2, wc = wid & 3, fr = lane & 15, fq = lane >> 4;
    int sR[2], sRb[2], sC[2];
#pragma unroll
    for (int i = 0; i < 2; ++i) { int R, C; stage_rc(tid * 16 + i * 8192, R, C); sR[i] = R; sRb[i] = (R & ~31) + perm32(R & 31); sC[i] = C * 2; }
    const size_t kstep = (size_t)(BK * 2);
    const unsigned ldsw = (unsigned)wid * 1024u;
    const int aoff = lds_byte(wr * 64 + fr, fq * 8), boff = lds_byte(wc * 32 + fr, fq * 8);
#define PG8_SA(b, h) (((b) * 2 + (h)) * HTB)
#define PG8_SB(b, h) ((4 + (b) * 2 + (h)) * HTB)
#define PG8_STAGE_(RR, bufoff, gbase, ld) do { _Pragma("unroll") for (int _i = 0; _i < 2; ++_i) \
        __builtin_amdgcn_global_load_lds((const unsigned*)((const char*)(gbase) + (unsigned)(RR[_i] * (ld) + sC[_i])), (LAS unsigned*)(lds + (bufoff) + ldsw + _i * 8192), 16, 0, 0); } while (0)
#define PG8_STAGE(bufoff, gbase, ld) do { if ((bufoff) >= 4 * HTB) PG8_STAGE_(sRb, bufoff, gbase, ld); else PG8_STAGE_(sR, bufoff, gbase, ld); } while (0)
#define PG8_LDA(dst, b, h) do { _Pragma("unroll") for (int m = 0; m < 4; ++m) _Pragma("unroll") for (int k = 0; k < 2; ++k) dst[m][k] = *(const LAS bf16x8*)(lds + PG8_SA(b, h) + aoff + m * 2048 + k * 1024); } while (0)
#define PG8_LDB(dst, b, h) do { _Pragma("unroll") for (int n = 0; n < 2; ++n) _Pragma("unroll") for (int k = 0; k < 2; ++k) dst[n][k] = *(const LAS bf16x8*)(lds + PG8_SB(b, h) + boff + n * 2048 + k * 1024); } while (0)
#define PG8_MMA(ai, bj, At, Bt) do { __builtin_amdgcn_s_setprio(1); _Pragma("unroll") for (int m = 0; m < 4; ++m) _Pragma("unroll") for (int n = 0; n < 2; ++n) _Pragma("unroll") for (int k = 0; k < 2; ++k) \
        acc[ai][bj][m][n] = __builtin_amdgcn_mfma_f32_16x16x32_bf16(Bt[n][k], At[m][k], acc[ai][bj][m][n], 0, 0, 0); __builtin_amdgcn_s_setprio(0); } while (0)
#define PG8_WAIT_V(n) asm volatile("s_waitcnt vmcnt(" #n ")" ::: "memory")
#define PG8_WAIT_L(n) asm volatile("s_waitcnt lgkmcnt(" #n ")" ::: "memory")
#define PG8_BAR __builtin_amdgcn_s_barrier()
#define PG8_SCHED __builtin_amdgcn_sched_barrier(0)
    Unit cur, nxt; int ui = 0;
    if (!S.next(0, cur)) return;
    f32x4 acc[2][2][4][2];
#pragma unroll
    for (int a = 0; a < 2; ++a)
#pragma unroll
        for (int b = 0; b < 2; ++b)
#pragma unroll
            for (int m = 0; m < 4; ++m)
#pragma unroll
                for (int n = 0; n < 2; ++n) acc[a][b][m][n] = (f32x4){0.f, 0.f, 0.f, 0.f};
    bf16x8 At[4][2], B0[2][2], B1[2][2];
    const char* cA = cur.A; const char* cB = cur.B; int clda = cur.lda, cldb = cur.ldb;
    {
        const size_t hA = (size_t)HALF * clda, hB = (size_t)HALF * cldb;
        PG8_STAGE(PG8_SB(0, 0), cB, cldb); PG8_STAGE(PG8_SB(0, 1), cB + hB, cldb); PG8_STAGE(PG8_SA(0, 0), cA, clda); PG8_STAGE(PG8_SA(0, 1), cA + hA, clda);
        if (wr == 1) PG8_BAR;
        PG8_WAIT_V(2); PG8_BAR;
        PG8_STAGE(PG8_SB(1, 0), cB + kstep, cldb); PG8_STAGE(PG8_SA(1, 0), cA + kstep, clda); PG8_STAGE(PG8_SB(1, 1), cB + hB + kstep, cldb);
        PG8_WAIT_V(6); PG8_BAR;
    }
    for (;;) {
        const bool has_next = S.next(ui + 1, nxt);
        const char* nA = has_next ? nxt.A : cA; const char* nB = has_next ? nxt.B : cB;
        const int nlda = has_next ? nxt.lda : clda, nldb = has_next ? nxt.ldb : cldb;
        const int nt = cur.nt;
        const size_t hA = (size_t)HALF * clda, hB = (size_t)HALF * cldb, nhA = (size_t)HALF * nlda, nhB = (size_t)HALF * nldb;
        for (int t = 0; t < nt; t += 2) {
            const bool last = (t == nt - 2);
            const char* a1 = cA + (size_t)(t + 1) * kstep;
            const char* a2 = last ? nA : cA + (size_t)(t + 2) * kstep; const char* b2 = last ? nB : cB + (size_t)(t + 2) * kstep;
            const char* a3 = a2 + kstep; const char* b3 = b2 + kstep;
            const int l2a = last ? nlda : clda, l2b = last ? nldb : cldb; const size_t h2a = last ? nhA : hA, h2b = last ? nhB : hB;
            PG8_LDB(B0, 0, 0); PG8_LDB(B1, 0, 1); PG8_SCHED; PG8_LDA(At, 0, 0); PG8_STAGE(PG8_SA(1, 1), a1 + hA, clda);
            PG8_WAIT_V(8); PG8_WAIT_L(0); PG8_BAR; PG8_MMA(0, 0, At, B0); PG8_MMA(0, 1, At, B1); PG8_BAR; PG8_SCHED;
            PG8_LDA(At, 0, 1); PG8_STAGE(PG8_SB(0, 0), b2, l2b); PG8_STAGE(PG8_SB(0, 1), b2 + h2b, l2b); PG8_STAGE(PG8_SA(0, 0), a2, l2a);
            PG8_WAIT_V(8); PG8_WAIT_L(0); PG8_BAR; PG8_MMA(1, 0, At, B0); PG8_MMA(1, 1, At, B1); PG8_BAR; PG8_SCHED;
            PG8_LDB(B0, 1, 0); PG8_LDB(B1, 1, 1); PG8_SCHED; PG8_LDA(At, 1, 0); PG8_STAGE(PG8_SA(0, 1), a2 + h2a, l2a);
            PG8_WAIT_V(8); PG8_WAIT_L(0); PG8_BAR; PG8_MMA(0, 0, At, B0); PG8_MMA(0, 1, At, B1); PG8_BAR; PG8_SCHED;
            PG8_LDA(At, 1, 1); PG8_STAGE(PG8_SB(1, 0), b3, l2b); PG8_STAGE(PG8_SB(1, 1), b3 + h2b, l2b); PG8_STAGE(PG8_SA(1, 0), a3, l2a);
            PG8_WAIT_V(8); PG8_WAIT_L(0); PG8_BAR; PG8_MMA(1, 0, At, B0); PG8_MMA(1, 1, At, B1); PG8_BAR; PG8_SCHED;
        }
        if (wr == 0) PG8_BAR;
        E(acc, cur, wr, wc, fr, fq, tid, lds);
        if (!has_next) break;
#pragma unroll
        for (int a = 0; a < 2; ++a)
#pragma unroll
            for (int b = 0; b < 2; ++b)
#pragma unroll
                for (int m = 0; m < 4; ++m)
#pragma unroll
                    for (int n = 0; n < 2; ++n) acc[a][b][m][n] = (f32x4){0.f, 0.f, 0.f, 0.f};
        cur = nxt; cA = nA; cB = nB; clda = nlda; cldb = nldb; ++ui;
        if (wr == 1) PG8_BAR;
    }
    PG8_WAIT_V(0);
    PG8_BAR;
#undef PG8_SA
#undef PG8_SB
#undef PG8_STAGE
#undef PG8_STAGE_
#undef PG8_LDA
#undef PG8_LDB
#undef PG8_MMA
#undef PG8_WAIT_V
#undef PG8_WAIT_L
#undef PG8_BAR
#undef PG8_SCHED
}
}

#define MFMA32(a, b, c) __builtin_amdgcn_mfma_f32_32x32x16_bf16((a), (b), (c), 0, 0, 0)
DI int crow(int i, int h) { return (i & 3) + 8 * (i >> 2) + 4 * h; }
typedef short v4i16_t __attribute__((ext_vector_type(4)));
DI s16x4 tr_read(const LAS unsigned char* p) { return __builtin_bit_cast(s16x4, __builtin_amdgcn_ds_read_tr16_b64_v4i16((LAS v4i16_t*)p)); }
DI float swap_max(float m) { auto rr = __builtin_amdgcn_permlane32_swap(__float_as_uint(m), __float_as_uint(m), false, false); return fmaxf(__uint_as_float(rr[0]), __uint_as_float(rr[1])); }
DI float swap_sum(float m) { auto rr = __builtin_amdgcn_permlane32_swap(__float_as_uint(m), __float_as_uint(m), false, false); return __uint_as_float(rr[0]) + __uint_as_float(rr[1]); }
DI bf16x8 pack8(const f32x16& x, int s) {
    u32x4 p; p[0] = pk2(x[8 * s], x[8 * s + 1]); p[1] = pk2(x[8 * s + 2], x[8 * s + 3]); p[2] = pk2(x[8 * s + 4], x[8 * s + 5]); p[3] = pk2(x[8 * s + 6], x[8 * s + 7]);
    return __builtin_bit_cast(bf16x8, p);
}

DI float max3f(float a, float b, float c) { float r; asm("v_max3_f32 %0, %1, %2, %3" : "=v"(r) : "v"(a), "v"(b), "v"(c)); return r; }
DI float max2f(float a, float b) { float r; asm("v_max_f32_e32 %0, %1, %2" : "=v"(r) : "v"(a), "v"(b)); return r; }
DI float rowmax32(const f32x16& p0, const f32x16& p1) {
    float a = max3f(p0[0], p0[1], p1[0]), b = max3f(p0[2], p0[3], p1[1]); a = max3f(a, p1[2], p1[3]);
#pragma unroll
    for (int r = 4; r < 16; r += 4) { a = max3f(a, p0[r], p0[r + 1]); b = max3f(b, p0[r + 2], p0[r + 3]); a = max3f(a, p1[r], p1[r + 1]); b = max3f(b, p1[r + 2], p1[r + 3]); }
    const float m = max2f(a, b);
    auto rr = __builtin_amdgcn_permlane32_swap(__float_as_uint(m), __float_as_uint(m), false, false);
    return max2f(__uint_as_float(rr[0]), __uint_as_float(rr[1]));
}
constexpr int AT_K0 = 0, AT_K1 = 16384, AT_V0 = 32768, AT_V1 = 49152, AT_SEL = 65536, AT_MISC = 66560 + 1024, AT_FLAG = 66560 + 2048;
constexpr int VP = 144;

template <int MODE>
DI void attn_unit(unsigned char* ws, int b, int h, int qb, LAS unsigned char* lds, bool do_store = true) {
    constexpr int DQK = MODE == 0 ? 96 : 64, NS = DQK / 16, KP = DQK * 2 + 16;
    constexpr int QPITCH = MODE == 0 ? 768 : 1536, KPITCH = MODE == 0 ? 1024 : 1536, OPITCH = MODE == 0 ? 512 : 1536;
    const bf16_t* Qb = (const bf16_t*)(ws + (MODE == 0 ? WS_QMLA : (MODE == 1 ? WS_SB : WS_MB)));
    const bf16_t* Kb = (const bf16_t*)(ws + (MODE == 0 ? WS_KVMLA : (MODE == 1 ? WS_SB : WS_MB)));
    bf16_t* Ob = (bf16_t*)(ws + (MODE == 0 ? WS_OMLA : (MODE == 1 ? WS_SB : WS_MB)));
    const bf16_t* KPEb = (const bf16_t*)(ws + WS_KPE);
    const int qcol = MODE == 0 ? h * 96 : h * 64, kcol = MODE == 0 ? h * 128 : 512 + h * 64, vcol = MODE == 0 ? h * 128 + 64 : 1024 + h * 64, ocol = h * 64;
    const int tid = tid_opaque(), lane = tid & 63, w = __builtin_amdgcn_readfirstlane(tid >> 6), r = lane & 31, hh = lane >> 5;
    const int q0 = qb * 256; const long rowbase = (long)b * SEQ;
    const int qg = q0 + 32 * w + r;
    bf16x8 qf[NS];
    { const bf16_t* qrow = Qb + (size_t)(rowbase + qg) * QPITCH + qcol + 8 * hh;
#pragma unroll
      for (int s = 0; s < NS; ++s) qf[s] = *(const bf16x8*)(qrow + 16 * s); }
    unsigned mysel = 0;
    if (MODE == 2) {
        if (tid < 256) {
            const bf16_t* qr = Qb + (size_t)(rowbase + q0 + tid) * QPITCH + qcol;
            float qv[64];
#pragma unroll
            for (int c8 = 0; c8 < 8; ++c8) { const u32x4 u = *(const u32x4*)(qr + c8 * 8);
#pragma unroll
                for (int e = 0; e < 4; ++e) { qv[c8 * 8 + 2 * e] = bf_lo(u[e]); qv[c8 * 8 + 2 * e + 1] = bf_hi(u[e]); } }
            const float* km = (const float*)(ws + WS_KMEAN) + (size_t)((b * 8 + h) * 16) * 64;
            float v0 = -INFINITY, v1 = -INFINITY, v2 = -INFINITY; int i0 = -1, i1 = -1, i2 = -1;
            for (int n = 0; n < qb; ++n) { float d = 0.f;
#pragma unroll
                for (int e = 0; e < 64; ++e) d += qv[e] * km[n * 64 + e];
                if (d > v0) { v2 = v1; i2 = i1; v1 = v0; i1 = i0; v0 = d; i0 = n; }
                else if (d > v1) { v2 = v1; i2 = i1; v1 = d; i1 = n; }
                else if (d > v2) { v2 = d; i2 = n; } }
            unsigned mk = 0; if (i0 >= 0) mk |= 1u << i0; if (i1 >= 0) mk |= 1u << i1; if (i2 >= 0) mk |= 1u << i2;
            *(LAS unsigned*)(lds + AT_SEL + tid * 4) = mk;
        }
        __syncthreads();
        mysel = *(LAS unsigned*)(lds + AT_SEL + (32 * w + r) * 4);
    }
    const int kkey = tid >> 3, kch = tid & 7, pkey = (tid & 255) >> 2, pch = tid & 3;
    u32x4 kr[2], vr[2], pr[2];
    pr[0] = (u32x4){0u, 0u, 0u, 0u}; pr[1] = pr[0];
#define AT_LOADG(kt, R) do { const size_t krow_ = (size_t)(rowbase + (kt) * 64 + kkey); \
        kr[R] = *(const u32x4*)(Kb + krow_ * KPITCH + kcol + kch * 8); vr[R] = *(const u32x4*)(Kb + krow_ * KPITCH + vcol + kch * 8); \
        if (MODE == 0 && tid < 256) pr[R] = *(const u32x4*)(KPEb + (size_t)(rowbase + (kt) * 64 + pkey) * 32 + pch * 8); } while (0)
#define AT_STORE(bf, R) do { *(LAS u32x4*)(lds + ((bf) ? AT_K1 : AT_K0) + kkey * KP + kch * 16) = kr[R]; *(LAS u32x4*)(lds + ((bf) ? AT_V1 : AT_V0) + kkey * VP + kch * 16) = vr[R]; \
        if (MODE == 0 && tid < 256) *(LAS u32x4*)(lds + ((bf) ? AT_K1 : AT_K0) + pkey * KP + 128 + pch * 16) = pr[R]; } while (0)
    const int kt_hi = qb * 4 + 3;
    AT_LOADG(kt_hi, 0); AT_LOADG(kt_hi - 1, 1); AT_STORE(0, 0);
    __syncthreads();
    f32x16 o0, o1;
#pragma unroll
    for (int i = 0; i < 16; ++i) { o0[i] = 0.f; o1[i] = 0.f; }
    float carry = 0.f; bool first = true;
    f32x16 lacc;
#pragma unroll
    for (int i = 0; i < 16; ++i) lacc[i] = 0.f;
    float refv = 0.f;
    const short kx0 = (hh == 0) ? (short)0xBF80 : (short)0;
    const bf16x8 kx = {kx0, 0, 0, 0, 0, 0, 0, 0};
    bf16x8 qx = {0, 0, 0, 0, 0, 0, 0, 0};
    const bf16x8 qbig = {(hh == 0) ? (short)0x7149 : (short)0, 0, 0, 0, 0, 0, 0, 0};
    f32x16 zero16;
#pragma unroll
    for (int i = 0; i < 16; ++i) zero16[i] = 0.f;
    const bf16x8 ones = {(short)0x3F80, (short)0x3F80, (short)0x3F80, (short)0x3F80, (short)0x3F80, (short)0x3F80, (short)0x3F80, (short)0x3F80};
    const int i16 = lane & 15, tq = i16 >> 2, tp = i16 & 3, blk = (lane >> 4) & 1;
    const int voff = (4 * hh + tq) * VP + (16 * blk + 4 * tp) * 2;
    const int qmin_w = q0 + 32 * w, qmax_w = qmin_w + 31;
    bool wfin = false, fin = false;
    int kt = kt_hi;
    for (;;) {
#pragma unroll
      for (int half = 0; half < 2; ++half) {
        if (kt >= 2) AT_LOADG(kt - 2, half);
        if (kt * 64 <= qmax_w && !wfin) {
            const LAS unsigned char* kb = lds + (half ? AT_K1 : AT_K0) + r * KP + hh * 16;
            f32x16 p0, p1;
#pragma unroll
            for (int s = 0; s < NS; ++s) {
                const bf16x8 k0 = *(const LAS bf16x8*)(kb + s * 32), k1 = *(const LAS bf16x8*)(kb + 32 * KP + s * 32);
                if (s == 0) { p0 = MFMA32(k0, qf[s], zero16); p1 = MFMA32(k1, qf[s], zero16); }
                else { p0 = MFMA32(k0, qf[s], p0); p1 = MFMA32(k1, qf[s], p1); }
            }
            if (MODE != 1) {
                bf16x8 qe = qx;
                if (MODE == 2) { const int nbk = kt >> 2; const bool dead = (nbk < qb) && !((mysel >> nbk) & 1u); qe = dead ? qbig : qx; }
                p0 = MFMA32(kx, qe, p0); p1 = MFMA32(kx, qe, p1);
            }
            bf16x8 vaf[4][2];
            { const LAS unsigned char* vb = lds + (half ? AT_V1 : AT_V0) + voff;
#pragma unroll
              for (int f = 0; f < 4; ++f) { const LAS unsigned char* vp = vb + (16 * f) * VP;
                  { const s16x4 lo = tr_read(vp), hi = tr_read(vp + 8 * VP); vaf[f][0] = __builtin_shufflevector(lo, hi, 0, 1, 2, 3, 4, 5, 6, 7); }
                  { const s16x4 lo = tr_read(vp + 64), hi = tr_read(vp + 8 * VP + 64); vaf[f][1] = __builtin_shufflevector(lo, hi, 0, 1, 2, 3, 4, 5, 6, 7); } } }
#define AT_PV(f, P, S2) do { const bf16x8 pf_ = pack8(P, S2); o0 = MFMA32(vaf[f][0], pf_, o0); o1 = MFMA32(vaf[f][1], pf_, o1); if (MODE != 1) lacc = MFMA32(ones, pf_, lacc); } while (0)
            const bool needmask = (kt * 64 + 63 >= qmin_w);
            const int kbase = kt * 64;
            if (MODE == 1) {
                f32x16 k0v, k1v;
#pragma unroll
                for (int i = 0; i < 16; ++i) {
                    { const float z = p0[i]; const float sp = fast_log(1.f + fast_exp(-fabsf(z))); float lb = fminf(z, 0.f) - sp; float lk = lb - z;
                      if (needmask && !(kbase + crow(i, hh) < qg)) { lb = -INFINITY; lk = 0.f; } p0[i] = lb; k0v[i] = lk; }
                    { const float z = p1[i]; const float sp = fast_log(1.f + fast_exp(-fabsf(z))); float lb = fminf(z, 0.f) - sp; float lk = lb - z;
                      if (needmask && !(kbase + 32 + crow(i, hh) < qg)) { lb = -INFINITY; lk = 0.f; } p1[i] = lb; k1v[i] = lk; }
                }
                float run = carry;
#pragma unroll
                for (int u = 7; u >= 0; --u) {
                    const int g = u & 3;
                    float gs = (u >= 4) ? ((k1v[4 * g] + k1v[4 * g + 1]) + (k1v[4 * g + 2] + k1v[4 * g + 3])) : ((k0v[4 * g] + k0v[4 * g + 1]) + (k0v[4 * g + 2] + k0v[4 * g + 3]));
                    auto rr = __builtin_amdgcn_permlane32_swap(__float_as_uint(gs), __float_as_uint(gs), false, false);
                    const float glo = __uint_as_float(rr[0]), ghi = __uint_as_float(rr[1]);
                    float a = run + (hh == 0 ? ghi : 0.f);
#pragma unroll
                    for (int jj = 3; jj >= 0; --jj) {
                        if (u >= 4) { const float lb = p1[4 * g + jj]; p1[4 * g + jj] = fast_exp(lb + a); a += k1v[4 * g + jj]; }
                        else { const float lb = p0[4 * g + jj]; p0[4 * g + jj] = fast_exp(lb + a); a += k0v[4 * g + jj]; }
                    }
                    run += glo + ghi;
                    if (u == 6) AT_PV(3, p1, 1); else if (u == 4) AT_PV(2, p1, 0); else if (u == 2) AT_PV(1, p0, 1); else if (u == 0) AT_PV(0, p0, 0);
                }
                carry = run;
                wfin = __all(carry < -110.f);
            } else {
                if (needmask) {
#pragma unroll
                    for (int i = 0; i < 16; ++i) { if (kbase + crow(i, hh) > qg) p0[i] = -INFINITY; if (kbase + 32 + crow(i, hh) > qg) p1[i] = -INFINITY; }
                }
                const float mt = rowmax32(p0, p1);
                if (first || __any(mt > 8.f)) {
                    const float delta = first ? (mt > -1e30f ? mt : 0.f) : (mt > 8.f ? mt : 0.f);
                    const unsigned nb16 = pk2(refv + delta, 0.f) & 0xffffu; const float nref = __uint_as_float(nb16 << 16);
                    const float d2 = nref - refv; const float sc = fast_exp2(-d2);
#pragma unroll
                    for (int i = 0; i < 16; ++i) { p0[i] -= d2; p1[i] -= d2; o0[i] *= sc; o1[i] *= sc; lacc[i] *= sc; }
                    refv = nref; qx[0] = (hh == 0) ? (short)nb16 : (short)0;
                    first = false;
                }
#pragma unroll
                for (int i = 0; i < 8; ++i) p0[i] = fast_exp2(p0[i]);
                AT_PV(0, p0, 0);
#pragma unroll
                for (int i = 8; i < 16; ++i) p0[i] = fast_exp2(p0[i]);
                AT_PV(1, p0, 1);
#pragma unroll
                for (int i = 0; i < 8; ++i) p1[i] = fast_exp2(p1[i]);
                AT_PV(2, p1, 0);
#pragma unroll
                for (int i = 8; i < 16; ++i) p1[i] = fast_exp2(p1[i]);
                AT_PV(3, p1, 1);
            }
#undef AT_PV
        }
        if (kt >= 1) AT_STORE(half ^ 1, half ^ 1);
        if (MODE == 1 && lane == 0) *(LAS unsigned*)(lds + AT_FLAG + half * 32 + w * 4) = wfin ? 1u : 0u;
        asm volatile("s_waitcnt lgkmcnt(0)" ::: "memory"); __builtin_amdgcn_s_barrier(); asm volatile("" ::: "memory");
        if (MODE == 1) { const u32x4 fa = *(const LAS u32x4*)(lds + AT_FLAG + half * 32), fb = *(const LAS u32x4*)(lds + AT_FLAG + half * 32 + 16);
            if ((fa.x & fa.y & fa.z & fa.w & fb.x & fb.y & fb.z & fb.w) != 0u) { fin = true; break; } }
        if (kt == 0) { fin = true; break; }
        --kt;
      }
      if (fin) break;
    }
    if (MODE != 1) { const float inv = 1.f / lacc[0];
#pragma unroll
        for (int i = 0; i < 16; ++i) { o0[i] *= inv; o1[i] *= inv; } }
    bf16_t* orow = Ob + (size_t)(rowbase + qg) * OPITCH + ocol + 4 * hh;
    if (do_store)
#pragma unroll
    for (int g = 0; g < 4; ++g) {
        u32x2 a, c; a.x = pk2(o0[4 * g], o0[4 * g + 1]); a.y = pk2(o0[4 * g + 2], o0[4 * g + 3]); c.x = pk2(o1[4 * g], o1[4 * g + 1]); c.y = pk2(o1[4 * g + 2], o1[4 * g + 3]);
        *(u32x2*)(orow + 8 * g) = a; *(u32x2*)(orow + 32 + 8 * g) = c;
    }
#undef AT_LOADG
#undef AT_STORE
}

DI void attn_phase(unsigned char* ws, LAS unsigned char* lds, unsigned* ctr, bool never) {
    const int tid = tid_opaque();
    for (;;) {
        __syncthreads();
        if (tid == 0) *(LAS int*)(lds + AT_MISC) = (int)atomicAdd(ctr, 1u);
        __syncthreads();
        const int u = *(LAS int*)(lds + AT_MISC);
        if (u >= 3072) break;
        if (u < 2048) { const int qb = 15 - (u >> 7), rem = u & 127, ty = rem >> 6, bh = rem & 63;
#ifdef PROBE_ATT2
            if (ty == 0) { attn_unit<0>(ws, bh >> 3, bh & 7, qb, lds, never); __syncthreads(); } else { attn_unit<2>(ws, bh >> 3, bh & 7, qb, lds, never); __syncthreads(); }
#endif
            if (ty == 0) attn_unit<0>(ws, bh >> 3, bh & 7, qb, lds); else attn_unit<2>(ws, bh >> 3, bh & 7, qb, lds); }
        else { const int v = u - 2048, qb = 15 - (v >> 6), bh = v & 63;
#ifdef PROBE_ATT2
            attn_unit<1>(ws, bh >> 3, bh & 7, qb, lds, never); __syncthreads();
#endif
            attn_unit<1>(ws, bh >> 3, bh & 7, qb, lds); }
    }
}

DI void cvt_T(const float* in, int K, int N, int ldin, bf16_t* out, int ldout, const float* gk, LAS float* tile, int& off) {
    const int tid = tid_opaque(), G = gridDim.x, kts = K / 64, nts = N / 32, ntile = kts * nts;
    for (int t = (int)((blockIdx.x + G - (off % G)) % G); t < ntile; t += G) {
        const int k0 = (t % kts) * 64, n0 = (t / kts) * 32;
#pragma unroll
        for (int i = 0; i < 4; ++i) { const int kl = (tid >> 5) + 16 * i, nl = tid & 31; float v = in[(size_t)(k0 + kl) * ldin + n0 + nl]; if (gk) v *= gk[k0 + kl]; tile[kl * 33 + nl] = v; }
        __syncthreads();
#pragma unroll
        for (int i = 0; i < 2; ++i) { const int nl = (tid >> 5) + 16 * i, kp = tid & 31;
            *(unsigned*)(out + (size_t)(n0 + nl) * ldout + k0 + 2 * kp) = pk2(tile[(2 * kp) * 33 + nl], tile[(2 * kp + 1) * 33 + nl]); }
        __syncthreads();
    }
    off += ntile;
}

DI void phase_bias(const Params& p, int l, LAS unsigned char* lds) {
    const int tid = tid_opaque(), lane = tid & 63, w = tid >> 6; unsigned char* ws = p.ws;
    LAS float* sh = (LAS float*)lds;
    LAS float* red = (LAS float*)(lds + 65536);
    const float* modl = (const float*)(ws + WS_MOD) + (size_t)l * 8 * 6144;
    bool staged = false;
    for (int it = (int)((blockIdx.x + 128) % gridDim.x); it < 177; it += gridDim.x) {
        if (!staged) { for (int i = tid; i < 8192; i += NTHREADS) { sh[i] = modl[(i >> 10) * 6144 + (i & 1023)]; sh[8192 + i] = modl[(i >> 10) * 6144 + 3072 + (i & 1023)]; } staged = true; }
        __syncthreads();
        const bool isin = it < 113; const int n = (isin ? it : it - 113) * 64 + lane; const int ld = isin ? 7200 : 4096; const bool valid = n < ld;
        const float* wa = (isin ? p.w_in + (size_t)l * 1024 * 7200 : p.w_ff1 + (size_t)l * 1024 * 4096) + (valid ? n : 0);
        const LAS float* shp = sh + (isin ? 0 : 8192);
        float a[8];
#pragma unroll
        for (int b = 0; b < 8; ++b) a[b] = 0.f;
#pragma unroll 16
        for (int k = w * 128; k < w * 128 + 128; ++k) { const float wv = wa[(size_t)k * ld];
#pragma unroll
            for (int b = 0; b < 8; ++b) a[b] += shp[b * 1024 + k] * wv; }
#pragma unroll
        for (int b = 0; b < 8; ++b) red[(w * 8 + b) * 64 + lane] = a[b];
        __syncthreads();
        { const int b = w; float sacc = 0.f;
#pragma unroll
          for (int ww = 0; ww < 8; ++ww) sacc += red[(ww * 8 + b) * 64 + lane];
          if (valid) { if (isin) ((float*)(ws + WS_BIAS1))[(size_t)(l * 8 + b) * NWIN + (n < 1056 ? n : n + 224)] = sacc; else ((float*)(ws + WS_BIAS2))[(size_t)(l * 8 + b) * 4096 + n] = sacc; } }
        __syncthreads();
    }
}

DI void phase_convert(const Params& p, int l, LAS unsigned char* lds) {
    LAS float* tile = (LAS float*)lds; unsigned char* ws = p.ws; int off = 0;
    const float* win = p.w_in + (size_t)l * 1024 * 7200;
    cvt_T(win, 1024, 1056, 7200, (bf16_t*)(ws + W_IN), 1024, nullptr, tile, off);
    cvt_T(win + 1056, 1024, 6144, 7200, (bf16_t*)(ws + W_IN) + (size_t)1280 * 1024, 1024, nullptr, tile, off);
    { u32x4* z = (u32x4*)((bf16_t*)(ws + W_IN) + (size_t)1056 * 1024); const int n = 224 * 1024 * 2 / 16;
      for (int i = blockIdx.x * NTHREADS + tid_opaque(); i < n; i += gridDim.x * NTHREADS) z[i] = (u32x4){0u, 0u, 0u, 0u}; }
    cvt_T(p.w_uq + (size_t)l * 768 * 768, 768, 768, 768, (bf16_t*)(ws + W_UQ), 768, p.q_norm_g + l * 768, tile, off);
    cvt_T(p.w_ukv + (size_t)l * 256 * 1024, 256, 1024, 1024, (bf16_t*)(ws + W_UKV), 256, p.kv_norm_g + l * 256, tile, off);
    cvt_T(p.w_o_mla + (size_t)l * 512 * 1024, 512, 1024, 1024, (bf16_t*)(ws + W_O), 512, nullptr, tile, off);
    cvt_T(p.w_o_sb + (size_t)l * 512 * 1024, 512, 1024, 1024, (bf16_t*)(ws + W_O) + (size_t)1024 * 512, 512, nullptr, tile, off);
    cvt_T(p.w_o_moba + (size_t)l * 512 * 1024, 512, 1024, 1024, (bf16_t*)(ws + W_O) + (size_t)2048 * 512, 512, nullptr, tile, off);
    cvt_T(p.w_out + (size_t)l * 1024 * 1024, 1024, 1024, 1024, (bf16_t*)(ws + W_OUT), 1024, nullptr, tile, off);
    cvt_T(p.w_ff1 + (size_t)l * 1024 * 4096, 1024, 4096, 4096, (bf16_t*)(ws + W_FF1), 1024, nullptr, tile, off);
    cvt_T(p.w_ff2 + (size_t)l * 4096 * 1024, 4096, 1024, 1024, (bf16_t*)(ws + W_FF2), 4096, nullptr, tile, off);
}

DI void phase_pre(const float* xin, const float* g, const float* modl, bf16_t* hdn, float* ssq) {
    const int tid = tid_opaque(), lane = tid & 63, w = tid >> 6;
    for (int row = blockIdx.x * 16 + w * 2; row < T; row += gridDim.x * 16) {
        f32x4 v[2][4];
#pragma unroll
        for (int rr = 0; rr < 2; ++rr) { const f32x4* xr = (const f32x4*)(xin + (size_t)(row + rr) * 1024) + lane;
#pragma unroll
            for (int j = 0; j < 4; ++j) v[rr][j] = xr[64 * j]; }
#pragma unroll
        for (int rr = 0; rr < 2; ++rr) { float s = 0.f;
#pragma unroll
            for (int j = 0; j < 4; ++j) s += (v[rr][j][0] * v[rr][j][0] + v[rr][j][1] * v[rr][j][1]) + (v[rr][j][2] * v[rr][j][2] + v[rr][j][3] * v[rr][j][3]);
            s = wave_sum(s); if (lane < 16) ssq[(size_t)(row + rr) * 16 + lane] = lane == 0 ? s : 0.f;
            const float* mb = modl + ((row + rr) >> 12) * 6144 + 1024;
#pragma unroll
            for (int j = 0; j < 4; ++j) { const int col = 4 * (lane + 64 * j);
                const f32x4 gg = *(const f32x4*)(g + col), sc = *(const f32x4*)(mb + col);
                *(u32x2*)(hdn + (size_t)(row + rr) * 1024 + col) = pk4(v[rr][j] * gg * (sc + 1.f)); } }
    }
}
DI void phase_final(float* xo, const bf16_t* xb, const float* g, const float* ssq) {
    const int tid = tid_opaque();
    for (int i = blockIdx.x * NTHREADS + tid; i < T * 128; i += gridDim.x * NTHREADS) {
        const int row = i >> 7, col = (i & 127) * 8; const float rstd = 1.f / sqrtf(sum16(ssq + (size_t)row * 16) * (1.f / 1024.f) + EPS);
        const u32x4 u = *(const u32x4*)(xb + (size_t)row * 1024 + col); const f32x4 g0 = *(const f32x4*)(g + col), g1 = *(const f32x4*)(g + col + 4);
        f32x4 a = {bf_lo(u.x), bf_hi(u.x), bf_lo(u.y), bf_hi(u.y)}, b = {bf_lo(u.z), bf_hi(u.z), bf_lo(u.w), bf_hi(u.w)};
        *(f32x4*)(xo + (size_t)row * 1024 + col) = (a * rstd) * g0; *(f32x4*)(xo + (size_t)row * 1024 + col + 4) = (b * rstd) * g1;
    }
}

DI void phase0(const Params& p, LAS unsigned char* lds) {
    const int tid = tid_opaque(), lane = tid & 63, w = tid >> 6; unsigned char* ws = p.ws;
    if (blockIdx.x == 0 && tid < 64) ((unsigned*)(ws + WS_CTR))[tid] = 0u;
    LAS float* cs = (LAS float*)lds;
    LAS float* red = (LAS float*)(lds + 32768);
    bool staged = false;
    for (int it = blockIdx.x; it < 192; it += gridDim.x) {
        if (!staged) { for (int i = tid; i < 8192; i += NTHREADS) { const float cv = p.c[i]; cs[i] = cv / (1.f + __expf(-cv)); } staged = true; }
        __syncthreads();
        const int l = it / 96, n = (it % 96) * 64 + lane;
        const float* wa = p.w_ada + (size_t)l * 1024 * 6144 + n;
        float a[8];
#pragma unroll
        for (int b = 0; b < 8; ++b) a[b] = 0.f;
#pragma unroll 16
        for (int k = w * 128; k < w * 128 + 128; ++k) { const float wv = wa[(size_t)k * 6144];
#pragma unroll
            for (int b = 0; b < 8; ++b) a[b] += cs[b * 1024 + k] * wv; }
#pragma unroll
        for (int b = 0; b < 8; ++b) red[(w * 8 + b) * 64 + lane] = a[b];
        __syncthreads();
        { const int b = w; float s = p.b_ada[l * 6144 + n];
#pragma unroll
          for (int ww = 0; ww < 8; ++ww) s += red[(ww * 8 + b) * 64 + lane];
          ((float*)(ws + WS_MOD))[(size_t)(l * 8 + b) * 6144 + n] = s; }
        __syncthreads();
    }
    const float L2T = 18.931568569324174f;
    float* rm = (float*)(ws + WS_ROPEM); float* rb = (float*)(ws + WS_ROPEB);
    for (int i = blockIdx.x * NTHREADS + tid; i < T * 24; i += gridDim.x * NTHREADS) {
        const int tok = i / 24, j = i % 24; const float ps = (float)p.pos[tok];
        float inv; if (j < 16) inv = exp2f(-(float)j * (L2T / 16.f)); else inv = exp2f(-(float)(j - 16) * (L2T / 8.f));
        const float ang = ps * inv; const double rev = (double)ang * 0.15915494309189535; const float fr = (float)(rev - rint(rev));
        const float sn = __builtin_amdgcn_sinf(fr), cn = __builtin_amdgcn_cosf(fr);
        if (j < 16) { rm[(size_t)tok * 32 + j] = cn; rm[(size_t)tok * 32 + 16 + j] = sn; } else { rb[(size_t)tok * 16 + (j - 16)] = cn; rb[(size_t)tok * 16 + 8 + (j - 16)] = sn; }
    }
}

DI void phase_kmean(unsigned char* ws, LAS unsigned char* lds) {
    const int tid = tid_opaque(); LAS float* red = (LAS float*)lds;
    const bf16_t* mb = (const bf16_t*)(ws + WS_MB); float* km = (float*)(ws + WS_KMEAN);
    for (int it = blockIdx.x; it < 1024; it += gridDim.x) {
        const int b = it >> 7, h = (it >> 4) & 7, nb = it & 15, c8 = tid & 7, j0 = tid >> 3;
        float s[8];
#pragma unroll
        for (int e = 0; e < 8; ++e) s[e] = 0.f;
#pragma unroll
        for (int jj = 0; jj < 4; ++jj) { const size_t row = (size_t)b * SEQ + nb * 256 + j0 + 64 * jj; const u32x4 u = *(const u32x4*)(mb + row * 1536 + 512 + h * 64 + c8 * 8);
#pragma unroll
            for (int e = 0; e < 4; ++e) { s[2 * e] += bf_lo(u[e]); s[2 * e + 1] += bf_hi(u[e]); } }
#pragma unroll
        for (int e = 0; e < 8; ++e) red[j0 * 65 + c8 * 8 + e] = s[e];
        __syncthreads();
        if (tid < 64) { float t = 0.f; for (int j = 0; j < 64; ++j) t += red[j * 65 + tid]; km[(size_t)it * 64 + tid] = t * (1.f / 256.f); }
        __syncthreads();
    }
}

#define XB_TMO      128
#define XB_XCNT(j)  (256  + 64 * (j))
#define XB_XSUB(j)  (1280 + 64 * (j))
#define XB_XGEN(j)  (2304 + 64 * (j))
#define XB_TOP      3328
#define XB_TOPGEN   3392
#define XCD_BAR_WORDS 3456
#define XB_SPIN_CAP (1u << 22)
DI unsigned xb_ld(unsigned* p)              { return __hip_atomic_load(p, __ATOMIC_RELAXED, __HIP_MEMORY_SCOPE_AGENT); }
DI unsigned xb_add(unsigned* p, unsigned v) { return __hip_atomic_fetch_add(p, v, __ATOMIC_RELAXED, __HIP_MEMORY_SCOPE_AGENT); }
DI unsigned xb_xcc_id() { return (unsigned)__builtin_amdgcn_s_getreg((3 << 11) | 20) & 0xFu; }
#define XB_SPIN(cond, bar) do { unsigned _sp = 0; while (cond) { __builtin_amdgcn_s_sleep(1); \
    if ((++_sp & 255u) == 0u) { if (xb_ld(&(bar)[XB_TMO])) break; if (_sp > XB_SPIN_CAP) { atomicAdd(&(bar)[XB_TMO], 1u); break; } } } } while (0)
struct XcdBarrier { unsigned* bar; unsigned x; volatile LAS unsigned* st; };
DI XcdBarrier xcd_barrier_post(unsigned* bar, volatile LAS unsigned* st) {
    XcdBarrier b; b.bar = bar; b.x = xb_xcc_id(); b.st = st;
    if (threadIdx.x == 0) (void)xb_add(&bar[XB_XCNT(b.x)], 1u);
    return b;
}
DI void xcd_barrier_complete(unsigned* bar, unsigned x, unsigned& nloc, unsigned& nx) {
    const unsigned G = gridDim.x * gridDim.y * gridDim.z;
    unsigned sum, cnt, mine, sp = 0u;
    for (;;) {
        sum = 0u; cnt = 0u; mine = 0u;
#pragma unroll
        for (unsigned j = 0; j < 16; ++j) { const unsigned c = xb_ld(&bar[XB_XCNT(j)]); sum += c; cnt += (c > 0u) ? 1u : 0u; mine = (j == x) ? c : mine; }
        if (sum == G) break;
        __builtin_amdgcn_s_sleep(1);
        if ((++sp & 255u) == 0u) { if (xb_ld(&bar[XB_TMO])) break; if (sp > XB_SPIN_CAP) { atomicAdd(&bar[XB_TMO], 1u); break; } }
    }
    nloc = mine > 0u ? mine : 1u; nx = cnt > 0u ? cnt : 1u;
}
DI void xcd_barrier(const XcdBarrier& b) {
    asm volatile("s_waitcnt vmcnt(0)" ::: "memory");
    __syncthreads();
    if (threadIdx.x == 0) {
        unsigned* bar = b.bar;
        __builtin_amdgcn_s_waitcnt(0);
        unsigned nloc = b.st[0], nx = b.st[1];
        if (nloc == 0u) { xcd_barrier_complete(bar, b.x, nloc, nx); b.st[0] = nloc; b.st[1] = nx; }
        const unsigned old = xb_add(&bar[XB_XSUB(b.x)], 1u);
        const unsigned gen = old / nloc;
        if (old + 1u == (gen + 1u) * nloc) {
            __builtin_amdgcn_fence(__ATOMIC_RELEASE, "agent");
            asm volatile("s_waitcnt vmcnt(0)" ::: "memory");
            const unsigned og = xb_add(&bar[XB_TOP], 1u);
            const unsigned tg = og / nx;
            if (og + 1u == (tg + 1u) * nx) xb_add(&bar[XB_TOPGEN], 1u);
            else XB_SPIN(xb_ld(&bar[XB_TOPGEN]) == tg, bar);
            __builtin_amdgcn_fence(__ATOMIC_ACQUIRE, "agent");
            xb_add(&bar[XB_XGEN(b.x)], 1u);
            asm volatile("s_waitcnt vmcnt(0)" ::: "memory");
        } else {
            XB_SPIN(xb_ld(&bar[XB_XGEN(b.x)]) == gen, bar);
            __builtin_amdgcn_fence(__ATOMIC_ACQUIRE, "agent");
            asm volatile("s_waitcnt vmcnt(0)" ::: "memory");
        }
    }
    __syncthreads();
}
constexpr size_t WS_BAR = 4096;
constexpr int NPHASE = 18;
__global__ void __launch_bounds__(NTHREADS, 2) fwd_kernel(Params p_unused) {
#if defined(__HIP_DEVICE_COMPILE__)
    extern __shared__ __attribute__((aligned(16))) unsigned char lds_raw[];
    LAS unsigned char* lds = (LAS unsigned char*)lds_raw;
    cg::grid_group grid = cg::this_grid();
    PP pk = (PP)__builtin_amdgcn_kernarg_segment_ptr();
    const int ph_lo = pk->ph_lo, ph_hi = pk->ph_hi;
    volatile LAS unsigned* xst = (volatile LAS unsigned*)(lds + 131072 + 4096);
    if (threadIdx.x == 0) { xst[0] = 0u; xst[1] = 0u; }
    __syncthreads();
    const XcdBarrier xbar = xcd_barrier_post((unsigned*)(pk->ws + WS_BAR), xst);
    for (int ph = ph_lo; ph < ph_hi; ++ph) {
        if (ph > ph_lo) { if (ph == ph_lo + 1) grid.sync(); else xcd_barrier(xbar); }
        PP pp = pk; asm volatile("" : "+s"(pp));
        if (ph == 0) { const Params p = *pp; phase0(p, lds); continue; }
        if (ph == NPHASE - 1) { phase_final(pp->out, (const bf16_t*)(pp->ws + WS_HDN), pp->final_g, (const float*)(pp->ws + WS_SSQXP) + (size_t)2 * T * 16); continue; }
        const int l = (ph - 1) >> 3, s = (ph - 1) & 7;
        if (s == 0) {
            const Params p = *pp; unsigned char* ws = p.ws;
            phase_convert(p, l, lds);
            __syncthreads();
            phase_bias(p, l, lds);
            if (l == 0) phase_pre(p.x, p.norm1_g, (const float*)(ws + WS_MOD), (bf16_t*)(ws + WS_HDN), (float*)(ws + WS_SSQXP));
        } else if (s == 3) {
            unsigned char* ws = pp->ws;
            attn_phase(ws, lds, (unsigned*)(ws + WS_CTR) + l, ph_hi == 12345);
        } else {
            unsigned char* ws = pp->ws;
            pg8::Sched S; S.G = gridDim.x; S.c = blockIdx.x; S.ws = (const char*)ws;
            pg8::Epi E; E.pp = pk; E.l = l;
            S.mode = s == 1 ? pg8::M_PROJ : (s == 2 ? pg8::M_UP : (s == 4 ? pg8::M_MERGE : (s == 5 ? pg8::M_OUT : (s == 6 ? pg8::M_FF1 : pg8::M_FF2))));
            pg8::gemm_phase(lds, S, E);
            if (s == 2) phase_kmean(ws, lds);
        }
    }
#endif
}

extern "C" void kernel_launch(void* const* d_in, const int* in_sizes, int n_in, void* d_out, int out_size, void* d_ws, size_t ws_size, hipStream_t stream) {
    static int grid = 0;
    if (grid == 0) {
        if (n_in != 19 || in_sizes[0] != T * DM || out_size != T * DM || ws_size < WS_END) {
            fprintf(stderr, "kernel_launch: unexpected shapes/workspace (n_in %d, in0 %d, out %d, ws %zu; need ws >= %zu); nothing launched\n", n_in, n_in > 0 ? in_sizes[0] : -1, out_size, ws_size, (size_t)WS_END);
            grid = -1; return; }
        int dev = 0, cus = 0, per_cu = 0;
        hipGetDevice(&dev); hipDeviceGetAttribute(&cus, hipDeviceAttributeMultiprocessorCount, dev);
        if (hipFuncSetAttribute((const void*)fwd_kernel, hipFuncAttributeMaxDynamicSharedMemorySize, LDS_BYTES) != hipSuccess) { fprintf(stderr, "kernel_launch: hipFuncSetAttribute failed\n"); grid = -1; return; }
        if (hipOccupancyMaxActiveBlocksPerMultiprocessor(&per_cu, (const void*)fwd_kernel, NTHREADS, LDS_BYTES) != hipSuccess || per_cu < 1) { fprintf(stderr, "kernel_launch: occupancy query says %d blocks/CU\n", per_cu); per_cu = 1; }
        (void)hipGetLastError();
        grid = cus * per_cu; if (grid > 256) grid = 256; if (grid % 8) grid -= grid % 8;
    }
    if (grid <= 0) return;
    Params p{};
    p.x = (const float*)d_in[0]; p.c = (const float*)d_in[1]; p.pos = (const int*)d_in[2]; p.w_ada = (const float*)d_in[3]; p.b_ada = (const float*)d_in[4];
    p.norm1_g = (const float*)d_in[5]; p.norm2_g = (const float*)d_in[6]; p.w_in = (const float*)d_in[7]; p.q_norm_g = (const float*)d_in[8]; p.w_uq = (const float*)d_in[9];
    p.kv_norm_g = (const float*)d_in[10]; p.w_ukv = (const float*)d_in[11]; p.w_o_mla = (const float*)d_in[12]; p.w_o_sb = (const float*)d_in[13]; p.w_o_moba = (const float*)d_in[14];
    p.w_out = (const float*)d_in[15]; p.w_ff1 = (const float*)d_in[16]; p.w_ff2 = (const float*)d_in[17]; p.final_g = (const float*)d_in[18];
    p.out = (float*)d_out; p.ws = (unsigned char*)d_ws; p.ph_lo = 0; p.ph_hi = NPHASE;
    (void)hipMemsetAsync((char*)d_ws + WS_BAR, 0, 16384, stream);
    void* args[] = {&p};
    hipError_t e = hipLaunchCooperativeKernel((const void*)fwd_kernel, dim3(grid), dim3(NTHREADS), args, LDS_BYTES, stream);
    if (e != hipSuccess) fprintf(stderr, "kernel_launch: cooperative launch failed: %s (grid %d)\n", hipGetErrorString(e), grid);
}
```

```cpp
#include <hip/hip_runtime.h>
#include <hip/hip_cooperative_groups.h>
#include <cstdio>
#include <cstdint>
namespace cg = cooperative_groups;

#define LAS __attribute__((address_space(3)))
#define DI __device__ __forceinline__
typedef unsigned short bf16_t;
typedef short bf16x8 __attribute__((ext_vector_type(8)));
typedef short s16x4 __attribute__((ext_vector_type(4)));
typedef float f32x4 __attribute__((ext_vector_type(4)));
typedef float f32x2 __attribute__((ext_vector_type(2)));
typedef float f32x16 __attribute__((ext_vector_type(16)));
typedef unsigned u32x4 __attribute__((ext_vector_type(4)));
typedef unsigned u32x2 __attribute__((ext_vector_type(2)));
typedef __bf16 bf16x2_t __attribute__((ext_vector_type(2)));

constexpr int T = 32768, SEQ = 4096, NB = 8, DM = 1024, DFF = 4096, DEPTH = 2;
constexpr float EPS = 1e-6f;
constexpr float LOG2E = 1.4426950408889634f;
constexpr float C_MLA = 0.10206207261596577f * LOG2E;
constexpr float C_MB = 0.125f * LOG2E;
constexpr int NWIN = 7424;

constexpr size_t MiB = 1u << 20;
constexpr size_t WS_CTR = 0;
constexpr size_t WS_MOD = 1 * MiB;
constexpr size_t WS_SSQQ = 2 * MiB;
constexpr size_t WS_SSQKV = 2 * MiB + 256 * 1024;
constexpr size_t WS_SSQX = 2 * MiB + 512 * 1024;
constexpr size_t WS_KMEAN = 3 * MiB;
constexpr size_t WS_ROPEM = 4 * MiB;
constexpr size_t WS_ROPEB = 8 * MiB;
constexpr size_t WS_BIAS1 = 10 * MiB;
constexpr size_t WS_BIAS2 = 11 * MiB;
constexpr size_t WS_W = 16 * MiB;
constexpr size_t W_IN = WS_W, W_UQ = WS_W + 15 * MiB, W_UKV = WS_W + 16 * MiB + 512 * 1024, W_O = WS_W + 17 * MiB, W_OUT = WS_W + 20 * MiB, W_FF1 = WS_W + 22 * MiB, W_FF2 = WS_W + 30 * MiB;
constexpr size_t WS_HDN = 56 * MiB;
constexpr size_t WS_QLAT = 120 * MiB;
constexpr size_t WS_CKV = 168 * MiB;
constexpr size_t WS_OMLA = 120 * MiB;
constexpr size_t WS_KPE = 184 * MiB;
constexpr size_t WS_SB = 186 * MiB;
constexpr size_t WS_MB = 282 * MiB;
constexpr size_t WS_QMLA = 378 * MiB;
constexpr size_t WS_STASH = 378 * MiB;
constexpr size_t WS_KVMLA = 426 * MiB;
constexpr size_t WS_MERGED = 426 * MiB;
constexpr size_t WS_H = 186 * MiB;
constexpr size_t WS_SSQXP = 490 * MiB;
constexpr size_t WS_SSQQP = 498 * MiB;
constexpr size_t WS_SSQKVP = 500 * MiB;
constexpr size_t WS_END = 502 * MiB;

constexpr int LDS_BYTES = 147456;
constexpr int NTHREADS = 512;

DI int tid_opaque() { int t = threadIdx.x; asm volatile("" : "+v"(t)); return t; }
DI unsigned pk2(float lo, float hi) { f32x2 v = {lo, hi}; bf16x2_t b = __builtin_convertvector(v, bf16x2_t); return __builtin_bit_cast(unsigned, b); }
DI float bf_lo(unsigned u) { return __uint_as_float(u << 16); }
DI float bf_hi(unsigned u) { return __uint_as_float(u & 0xffff0000u); }
DI u32x2 pk4(f32x4 v) { u32x2 r; r.x = pk2(v[0], v[1]); r.y = pk2(v[2], v[3]); return r; }
DI float wave_sum(float v) {
#pragma unroll
    for (int o = 32; o >= 1; o >>= 1) v += __shfl_xor(v, o);
    return v;
}
DI float fast_exp2(float x) { return __builtin_amdgcn_exp2f(x); }
DI float fast_exp(float x) { return __builtin_amdgcn_exp2f(x * LOG2E); }
DI float fast_log(float x) { return __builtin_amdgcn_logf(x) * 0.6931471805599453f; }
DI float sigmoidf_(float x) { return __builtin_amdgcn_rcpf(1.f + fast_exp(-x)); }

DI float sum16(const float* p) { const f32x4 a = *(const f32x4*)p, b = *(const f32x4*)(p + 4), c = *(const f32x4*)(p + 8), d = *(const f32x4*)(p + 12); return (((a[0] + a[1]) + (a[2] + a[3])) + ((b[0] + b[1]) + (b[2] + b[3]))) + (((c[0] + c[1]) + (c[2] + c[3])) + ((d[0] + d[1]) + (d[2] + d[3]))); }
DI float sum12(const float* p) { const f32x4 a = *(const f32x4*)p, b = *(const f32x4*)(p + 4), c = *(const f32x4*)(p + 8); return (((a[0] + a[1]) + (a[2] + a[3])) + ((b[0] + b[1]) + (b[2] + b[3]))) + ((c[0] + c[1]) + (c[2] + c[3])); }
DI float sum4(const float* p) { const f32x4 a = *(const f32x4*)p; return (a[0] + a[1]) + (a[2] + a[3]); }

struct Params {
    const float* x; const float* c; const int* pos; const float* w_ada; const float* b_ada; const float* norm1_g; const float* norm2_g;
    const float* w_in; const float* q_norm_g; const float* w_uq; const float* kv_norm_g; const float* w_ukv;
    const float* w_o_mla; const float* w_o_sb; const float* w_o_moba; const float* w_out; const float* w_ff1; const float* w_ff2; const float* final_g;
    float* out; unsigned char* ws;
    int ph_lo, ph_hi;
};

typedef const Params __attribute__((address_space(4)))* PP;

namespace pg8 {
constexpr int BM = 256, BK = 64, HALF = 128, HTB = HALF * BK * 2, STAGE_BYTES = 8 * HTB, NXCD = 8, WGM = 8;
DI int lds_byte(int r, int c) { const int st = (r >> 4) * 2 + (c >> 5), rr = r & 15, cc = c & 31, ob = rr * 64 + cc * 2; return st * 1024 + (ob ^ (((ob >> 9) & 1) << 5)); }
DI int perm32(int rho) { const int n = rho >> 4, i = rho & 15; return 8 * (i >> 2) + 4 * n + (i & 3); }
DI void stage_rc(int b, int& R, int& C) { const int st = b / 1024, sb = b % 1024, swz = sb ^ (((sb >> 9) & 1) << 5); R = (st >> 1) * 16 + swz / 64; C = (st & 1) * 32 + (swz % 64) / 2; }

enum { K_QLAT = 0, K_CKV, K_KPE, K_SB, K_MB, K_UQ, K_UKV, K_GATE, K_BR0, K_BR1, K_BR2, K_OUT, K_FF1, K_FF2 };
enum { M_PROJ = 0, M_UP, M_MERGE, M_OUT, M_FF1, M_FF2 };

struct Unit { const char* A; const char* B; int lda, ldb; int nt, kind; int pm, pn; };

DI void tile_map(int L, int nM, int nN, int& pm, int& pn) {
    const int nwg = nM * nN; int wgid = L;
    { const int q = nwg / NXCD, r = nwg % NXCD, xcd = wgid % NXCD, off = wgid / NXCD; wgid = (xcd < r ? xcd * (q + 1) : r * (q + 1) + (xcd - r) * q) + off; }
    const int nig = WGM * nN, gid = wgid / nig, fm = gid * WGM, gsz = (nM - fm) < WGM ? (nM - fm) : WGM;
    pm = __builtin_amdgcn_readfirstlane(fm + ((wgid % nig) % gsz)); pn = __builtin_amdgcn_readfirstlane((wgid % nig) / gsz);
}

struct Sched {
    int mode, G, c; const char* ws;
    DI bool next(int i, Unit& u) const {
        const int nM = T / BM;
        if (mode == M_PROJ) {
            const long L = (long)i * G + c; if (L >= nM * 17) return false;
            tile_map((int)L, nM, 17, u.pm, u.pn);
            u.lda = 2048; u.ldb = 2048; u.nt = 16;
            u.A = ws + WS_HDN + (size_t)u.pm * BM * 2048; u.B = ws + W_IN + (size_t)u.pn * BM * 2048;
            u.kind = u.pn < 3 ? K_QLAT : (u.pn == 3 ? K_CKV : (u.pn == 4 ? K_KPE : (u.pn < 11 ? K_SB : K_MB)));
            return true;
        } else if (mode == M_UP) {
            const long L = (long)i * G + c; if (L >= nM * 7) return false;
            if (L < nM * 3) { tile_map((int)L, nM, 3, u.pm, u.pn); u.lda = 1536; u.ldb = 1536; u.nt = 12; u.kind = K_UQ;
                u.A = ws + WS_QLAT + (size_t)u.pm * BM * 1536; u.B = ws + W_UQ + (size_t)u.pn * BM * 1536; }
            else { tile_map((int)L - nM * 3, nM, 4, u.pm, u.pn); u.lda = 512; u.ldb = 512; u.nt = 4; u.kind = K_UKV;
                u.A = ws + WS_CKV + (size_t)u.pm * BM * 512; u.B = ws + W_UKV + (size_t)u.pn * BM * 512; }
            return true;
        } else if (mode == M_MERGE) {
            const int tl = i / 6, sub = i - tl * 6, br = sub >> 1;
            const long L = (long)tl * G + c; if (L >= nM * 4) return false;
            tile_map((int)L, nM, 4, u.pm, u.pn);
            if ((sub & 1) == 0) { u.lda = 2048; u.ldb = 2048; u.nt = 16; u.kind = K_GATE;
                u.A = ws + WS_HDN + (size_t)u.pm * BM * 2048; u.B = ws + W_IN + (size_t)(4352 + br * 1024 + u.pn * BM) * 2048; }
            else { u.ldb = 1024; u.nt = 8; u.kind = K_BR0 + br;
                u.lda = br == 0 ? 1024 : 3072;
                u.A = ws + (br == 0 ? WS_OMLA : (br == 1 ? WS_SB : WS_MB)) + (size_t)u.pm * BM * u.lda;
                u.B = ws + W_O + (size_t)(br * 1024 + u.pn * BM) * 1024; }
            return true;
        } else if (mode == M_OUT) {
            const long L = (long)i * G + c; if (L >= nM * 4) return false;
            tile_map((int)L, nM, 4, u.pm, u.pn); u.lda = 2048; u.ldb = 2048; u.nt = 16; u.kind = K_OUT;
            u.A = ws + WS_MERGED + (size_t)u.pm * BM * 2048; u.B = ws + W_OUT + (size_t)u.pn * BM * 2048; return true;
        } else if (mode == M_FF1) {
            const long L = (long)i * G + c; if (L >= nM * 16) return false;
            tile_map((int)L, nM, 16, u.pm, u.pn); u.lda = 2048; u.ldb = 2048; u.nt = 16; u.kind = K_FF1;
            u.A = ws + WS_HDN + (size_t)u.pm * BM * 2048; u.B = ws + W_FF1 + (size_t)u.pn * BM * 2048; return true;
        } else {
            const long L = (long)i * G + c; if (L >= nM * 4) return false;
            tile_map((int)L, nM, 4, u.pm, u.pn); u.lda = 8192; u.ldb = 8192; u.nt = 64; u.kind = K_FF2;
            u.A = ws + WS_H + (size_t)u.pm * BM * 8192; u.B = ws + W_FF2 + (size_t)u.pn * BM * 8192; return true;
        }
    }
};

struct Epi {
    PP pp; int l;
    template <int NS> DI void rowstat(float (&rs)[2][4], const float* parts, float inv_n, float mul, int rowbase_wave, LAS float* buf, int lane, int fr) const {
#pragma unroll
        for (int h = 0; h < 2; ++h) { const float* pp = parts + (size_t)(rowbase_wave + h * 128 + lane) * (NS == 4 ? 4 : 16);
            const float sm = NS == 16 ? sum16(pp) : (NS == 12 ? sum12(pp) : sum4(pp)); buf[h * 64 + lane] = __builtin_amdgcn_rsqf(sm * inv_n + EPS) * mul; }
#pragma unroll
        for (int ai = 0; ai < 2; ++ai)
#pragma unroll
            for (int m = 0; m < 4; ++m) rs[ai][m] = buf[ai * 64 + m * 16 + fr];
    }
    DI void operator()(const f32x4 (&acc)[2][2][4][2], const Unit& u, int wr, int wc, int fr, int fq, int tid, LAS unsigned char* lds) const {
        asm volatile("" : "+v"(fr), "+v"(fq), "+v"(tid));
        PP q = pp; asm volatile("" : "+s"(q));
        unsigned char* ws = q->ws; float* out = q->out; const float* xin = l == 0 ? q->x : q->out;
        const float* mod = (const float*)(ws + WS_MOD) + (size_t)l * 8 * 6144;
        float* ssqx = (float*)(ws + WS_SSQXP);
        const float* ssq1 = ssqx + (size_t)l * T * 16; float* ssq2 = ssqx + (size_t)3 * T * 16; float* ssqn = ssqx + (size_t)(l + 1) * T * 16;
        const float* bias1 = (const float*)(ws + WS_BIAS1) + (size_t)l * 8 * NWIN; const float* bias2 = (const float*)(ws + WS_BIAS2) + (size_t)l * 8 * 4096;
        const float* g2 = q->norm2_g + l * 1024; const float* g1n = q->norm1_g + ((l + 1) % DEPTH) * 1024; const float* modn = (const float*)(ws + WS_MOD) + (size_t)((l + 1) % DEPTH) * 8 * 6144;
        const int rbw = u.pm * BM + wr * 64, bidx = (u.pm * BM) >> 12;
#define EPI_CASE_BEGIN asm volatile("" : "+v"(fr), "+v"(fq), "+v"(tid)); const int row0 = u.pm * BM + wr * 64 + fr, lc0 = wc * 32 + fq * 8, lane = tid & 63; LAS float* rsbuf = (LAS float*)(lds + 131072) + (tid >> 6) * 128; float rs[2][4]; (void)row0; (void)lc0; (void)lane; (void)rsbuf; (void)rs;
#define PK8(v0, v1) ((u32x4){pk2((v0)[0], (v0)[1]), pk2((v0)[2], (v0)[3]), pk2((v1)[0], (v1)[1]), pk2((v1)[2], (v1)[3])})
        switch (u.kind) {
        case K_QLAT: case K_CKV: { EPI_CASE_BEGIN
            const bool isq = u.kind == K_QLAT;
            bf16_t* dst = (bf16_t*)(ws + (isq ? WS_QLAT : WS_CKV)); const int ld = isq ? 768 : 256; const int cb = isq ? u.pn * 256 : 0;
            float* ssq = (float*)(ws + (isq ? WS_SSQQP : WS_SSQKVP));
            rowstat<16>(rs, ssq1, 1.f / 1024.f, 1.f, rbw, rsbuf, lane, fr);
            f32x4 bv[2][2];
#pragma unroll
            for (int bj = 0; bj < 2; ++bj)
#pragma unroll
                for (int n = 0; n < 2; ++n) bv[bj][n] = *(const f32x4*)(bias1 + bidx * NWIN + u.pn * 256 + lc0 + bj * 128 + n * 4);
#pragma unroll
            for (int ai = 0; ai < 2; ++ai)
#pragma unroll
                for (int m = 0; m < 4; ++m) { const int row = row0 + ai * 128 + m * 16; float s = 0.f;
#pragma unroll
                    for (int bj = 0; bj < 2; ++bj) { const f32x4 v0 = acc[ai][bj][m][0] * rs[ai][m] + bv[bj][0], v1 = acc[ai][bj][m][1] * rs[ai][m] + bv[bj][1];
                        s += ((v0[0] * v0[0] + v0[1] * v0[1]) + (v0[2] * v0[2] + v0[3] * v0[3])) + ((v1[0] * v1[0] + v1[1] * v1[1]) + (v1[2] * v1[2] + v1[3] * v1[3]));
                        *(u32x4*)(dst + (size_t)row * ld + cb + lc0 + bj * 128) = PK8(v0, v1); }
                    s += __shfl_xor(s, 16); s += __shfl_xor(s, 32);
                    if (fq == 0) { if (isq) ssq[(size_t)row * 16 + u.pn * 4 + wc] = s; else ssq[(size_t)row * 4 + wc] = s; } }
        } break;
        case K_KPE: { EPI_CASE_BEGIN
            if (wc == 0) {
                bf16_t* dst = (bf16_t*)(ws + WS_KPE); const float* rt = (const float*)(ws + WS_ROPEM);
                rowstat<16>(rs, ssq1, 1.f / 1024.f, 1.f, rbw, rsbuf, lane, fr);
                const f32x4 b0 = *(const f32x4*)(bias1 + bidx * NWIN + 1024 + fq * 8), b1 = *(const f32x4*)(bias1 + bidx * NWIN + 1024 + fq * 8 + 4);
#pragma unroll
                for (int ai = 0; ai < 2; ++ai)
#pragma unroll
                    for (int m = 0; m < 4; ++m) { const int row = row0 + ai * 128 + m * 16;
                        const float* rr = rt + (size_t)row * 32 + (fq & 1) * 8;
                        const f32x4 cs0 = *(const f32x4*)rr, cs1 = *(const f32x4*)(rr + 4), sn0 = *(const f32x4*)(rr + 16), sn1 = *(const f32x4*)(rr + 20);
                        const f32x4 v0 = acc[ai][0][m][0] * rs[ai][m] + b0, v1 = acc[ai][0][m][1] * rs[ai][m] + b1; f32x4 p0, p1;
#pragma unroll
                        for (int e = 0; e < 4; ++e) { p0[e] = __shfl_xor(v0[e], 32); p1[e] = __shfl_xor(v1[e], 32); }
                        const f32x4 o0 = fq < 2 ? (v0 * cs0 - p0 * sn0) : (p0 * sn0 + v0 * cs0), o1 = fq < 2 ? (v1 * cs1 - p1 * sn1) : (p1 * sn1 + v1 * cs1);
                        *(u32x4*)(dst + (size_t)row * 32 + fq * 8) = PK8(o0, o1); }
            }
        } break;
        case K_SB: case K_MB: { EPI_CASE_BEGIN
            const bool ismb = u.kind == K_MB;
            const int t = u.pn - (ismb ? 11 : 5); bf16_t* dst = (bf16_t*)(ws + (ismb ? WS_MB : WS_SB)); const float sc = t < 2 ? C_MB : 1.f;   const float* rt = (const float*)(ws + WS_ROPEB);
            const bool rope = ismb && (t < 4) && ((wc & 1) == 0);
            rowstat<16>(rs, ssq1, 1.f / 1024.f, 1.f, rbw, rsbuf, lane, fr);
            f32x4 bv[2][2];
#pragma unroll
            for (int bj = 0; bj < 2; ++bj)
#pragma unroll
                for (int n = 0; n < 2; ++n) bv[bj][n] = *(const f32x4*)(bias1 + bidx * NWIN + u.pn * 256 + lc0 + bj * 128 + n * 4);
#pragma unroll
            for (int ai = 0; ai < 2; ++ai)
#pragma unroll
                for (int m = 0; m < 4; ++m) { const int row = row0 + ai * 128 + m * 16;
                    f32x4 cs0 = {1.f, 1.f, 1.f, 1.f}, cs1 = cs0, sn0 = {0.f, 0.f, 0.f, 0.f}, sn1 = sn0;
                    if (rope) { const float* rr = rt + (size_t)row * 16; cs0 = *(const f32x4*)rr; cs1 = *(const f32x4*)(rr + 4); sn0 = *(const f32x4*)(rr + 8); sn1 = *(const f32x4*)(rr + 12); }
#pragma unroll
                    for (int bj = 0; bj < 2; ++bj) { f32x4 v0 = acc[ai][bj][m][0] * rs[ai][m] + bv[bj][0], v1 = acc[ai][bj][m][1] * rs[ai][m] + bv[bj][1];
                        if (rope) { f32x4 p0, p1;
#pragma unroll
                            for (int e = 0; e < 4; ++e) { p0[e] = __shfl_xor(v0[e], 16); p1[e] = __shfl_xor(v1[e], 16); }
                            if (fq == 0) { v0 = v0 * cs0 - p0 * sn0; v1 = v1 * cs1 - p1 * sn1; } else if (fq == 1) { v0 = p0 * sn0 + v0 * cs0; v1 = p1 * sn1 + v1 * cs1; } }
                        v0 = v0 * sc; v1 = v1 * sc;
                        *(u32x4*)(dst + (size_t)row * 1536 + t * 256 + lc0 + bj * 128) = PK8(v0, v1); } }
        } break;
        case K_UQ: { EPI_CASE_BEGIN
            bf16_t* dst = (bf16_t*)(ws + WS_QMLA); const float* rt = (const float*)(ws + WS_ROPEM);
            rowstat<12>(rs, (const float*)(ws + WS_SSQQP), 1.f / 768.f, C_MLA, rbw, rsbuf, lane, fr);
#pragma unroll
            for (int ai = 0; ai < 2; ++ai)
#pragma unroll
                for (int m = 0; m < 4; ++m) { const int row = row0 + ai * 128 + m * 16;
                    const float* rr = rt + (size_t)row * 32 + (fq & 1) * 8;
                    const f32x4 cs0 = *(const f32x4*)rr, cs1 = *(const f32x4*)(rr + 4), sn0 = *(const f32x4*)(rr + 16), sn1 = *(const f32x4*)(rr + 20);
#pragma unroll
                    for (int bj = 0; bj < 2; ++bj) { const int gc = u.pn * 256 + bj * 128 + wc * 32; const bool pe = ((gc >> 5) % 3) == 2;
                        f32x4 v0 = acc[ai][bj][m][0] * rs[ai][m], v1 = acc[ai][bj][m][1] * rs[ai][m];
                        if (pe) { f32x4 p0, p1;
#pragma unroll
                            for (int e = 0; e < 4; ++e) { p0[e] = __shfl_xor(v0[e], 32); p1[e] = __shfl_xor(v1[e], 32); }
                            if (fq < 2) { v0 = v0 * cs0 - p0 * sn0; v1 = v1 * cs1 - p1 * sn1; } else { v0 = p0 * sn0 + v0 * cs0; v1 = p1 * sn1 + v1 * cs1; } }
                        *(u32x4*)(dst + (size_t)row * 768 + gc + fq * 8) = PK8(v0, v1); } }
        } break;
        case K_UKV: { EPI_CASE_BEGIN
            bf16_t* dst = (bf16_t*)(ws + WS_KVMLA);
            rowstat<4>(rs, (const float*)(ws + WS_SSQKVP), 1.f / 256.f, 1.f, rbw, rsbuf, lane, fr);
#pragma unroll
            for (int ai = 0; ai < 2; ++ai)
#pragma unroll
                for (int m = 0; m < 4; ++m) { const int row = row0 + ai * 128 + m * 16;
#pragma unroll
                    for (int bj = 0; bj < 2; ++bj) { const f32x4 v0 = acc[ai][bj][m][0] * rs[ai][m], v1 = acc[ai][bj][m][1] * rs[ai][m];
                        *(u32x4*)(dst + (size_t)row * 1024 + u.pn * 256 + lc0 + bj * 128) = PK8(v0, v1); } }
        } break;
        case K_GATE: { EPI_CASE_BEGIN
            u32x4* st = (u32x4*)(ws + WS_STASH + (size_t)blockIdx.x * 131072) + tid;
            const int gcol = (int)((u.B - (const char*)(ws + W_IN)) >> 11) + lc0;
            rowstat<16>(rs, ssq1, 1.f / 1024.f, 1.f, rbw, rsbuf, lane, fr);
            f32x4 bv[2][2];
#pragma unroll
            for (int bj = 0; bj < 2; ++bj)
#pragma unroll
                for (int n = 0; n < 2; ++n) bv[bj][n] = *(const f32x4*)(bias1 + bidx * NWIN + gcol + bj * 128 + n * 4);
#pragma unroll
            for (int ai = 0; ai < 2; ++ai)
#pragma unroll
                for (int m = 0; m < 4; ++m)
#pragma unroll
                    for (int bj = 0; bj < 2; ++bj) { f32x4 g0, g1;
                        const f32x4 a0 = acc[ai][bj][m][0] * rs[ai][m] + bv[bj][0], a1 = acc[ai][bj][m][1] * rs[ai][m] + bv[bj][1];
#pragma unroll
                        for (int e = 0; e < 4; ++e) { g0[e] = sigmoidf_(a0[e]); g1[e] = sigmoidf_(a1[e]); }
                        st[((ai * 4 + m) * 2 + bj) * 512] = PK8(g0, g1); }
        } break;
        case K_BR0: case K_BR1: case K_BR2: { EPI_CASE_BEGIN
            const u32x4* st = (const u32x4*)(ws + WS_STASH + (size_t)blockIdx.x * 131072) + tid; bf16_t* dst = (bf16_t*)(ws + WS_MERGED);
            const bool first = u.kind == K_BR0;
#pragma unroll
            for (int ai = 0; ai < 2; ++ai)
#pragma unroll
                for (int m = 0; m < 4; ++m) { const int row = row0 + ai * 128 + m * 16;
#pragma unroll
                    for (int bj = 0; bj < 2; ++bj) { const u32x4 g = st[((ai * 4 + m) * 2 + bj) * 512];
                        u32x4* d = (u32x4*)(dst + (size_t)row * 1024 + u.pn * 256 + lc0 + bj * 128);
                        const f32x4 a0 = acc[ai][bj][m][0], a1 = acc[ai][bj][m][1];
                        f32x4 r0 = {bf_lo(g.x) * a0[0], bf_hi(g.x) * a0[1], bf_lo(g.y) * a0[2], bf_hi(g.y) * a0[3]}, r1 = {bf_lo(g.z) * a1[0], bf_hi(g.z) * a1[1], bf_lo(g.w) * a1[2], bf_hi(g.w) * a1[3]};
                        if (!first) { const u32x4 o = *d; r0[0] += bf_lo(o.x); r0[1] += bf_hi(o.x); r0[2] += bf_lo(o.y); r0[3] += bf_hi(o.y); r1[0] += bf_lo(o.z); r1[1] += bf_hi(o.z); r1[2] += bf_lo(o.w); r1[3] += bf_hi(o.w); }
                        *d = PK8(r0, r1); } }
        } break;
        case K_OUT: case K_FF2: { EPI_CASE_BEGIN
            const bool isout = u.kind == K_OUT;
            const int goff = isout ? 2048 : 5120; const float* src = isout ? xin : out;
            const float* gn = isout ? g2 : g1n; const float* mn = isout ? mod + 4096 : modn + 1024;
            float* ssqo = isout ? ssq2 : ssqn; bf16_t* hd = (bf16_t*)(ws + WS_HDN);
            const bool lastff2 = !isout && (l + 1 == DEPTH);
            f32x4 gv[2][2], fac[2][2];
#pragma unroll
            for (int bj = 0; bj < 2; ++bj)
#pragma unroll
                for (int n = 0; n < 2; ++n) { const int col = u.pn * 256 + lc0 + bj * 128 + n * 4;
                    gv[bj][n] = *(const f32x4*)(mod + bidx * 6144 + goff + col);
                    fac[bj][n] = lastff2 ? (f32x4){1.f, 1.f, 1.f, 1.f} : *(const f32x4*)(gn + col) * (*(const f32x4*)(mn + bidx * 6144 + col) + 1.f); }
            bf16_t* xb = (bf16_t*)out;
            const bool f32res = isout && l == 0;
#pragma unroll
            for (int ai = 0; ai < 2; ++ai)
#pragma unroll
                for (int m = 0; m < 4; ++m) { __builtin_amdgcn_sched_barrier(0);
                    const size_t ro = (size_t)(row0 + ai * 128 + m * 16) * 1024 + u.pn * 256 + lc0; float sv = 0.f;
#pragma unroll
                    for (int bj = 0; bj < 2; ++bj) { const int co = bj * 128;
                        f32x4 r0, r1;
                        if (f32res) { r0 = *(const f32x4*)(src + ro + co); r1 = *(const f32x4*)(src + ro + co + 4); }
                        else { const u32x4 rb = *(const u32x4*)(xb + ro + co); r0 = (f32x4){bf_lo(rb.x), bf_hi(rb.x), bf_lo(rb.y), bf_hi(rb.y)}; r1 = (f32x4){bf_lo(rb.z), bf_hi(rb.z), bf_lo(rb.w), bf_hi(rb.w)}; }
                        const f32x4 x0 = r0 + gv[bj][0] * acc[ai][bj][m][0], x1 = r1 + gv[bj][1] * acc[ai][bj][m][1];
                        if (!lastff2) *(u32x4*)(xb + ro + co) = PK8(x0, x1);
                        sv += ((x0[0] * x0[0] + x0[1] * x0[1]) + (x0[2] * x0[2] + x0[3] * x0[3])) + ((x1[0] * x1[0] + x1[1] * x1[1]) + (x1[2] * x1[2] + x1[3] * x1[3]));
                        const f32x4 h0 = x0 * fac[bj][0], h1 = x1 * fac[bj][1];
                        *(u32x4*)(hd + ro + co) = PK8(h0, h1); }
                    sv += __shfl_xor(sv, 16); sv += __shfl_xor(sv, 32);
                    if (fq == 0) ssqo[(size_t)(row0 + ai * 128 + m * 16) * 16 + u.pn * 4 + wc] = sv; }
        } break;
        case K_FF1: { EPI_CASE_BEGIN
            bf16_t* dst = (bf16_t*)(ws + WS_H);
            rowstat<16>(rs, ssq2, 1.f / 1024.f, 1.f, rbw, rsbuf, lane, fr);
            f32x4 bv[2][2];
#pragma unroll
            for (int bj = 0; bj < 2; ++bj)
#pragma unroll
                for (int n = 0; n < 2; ++n) bv[bj][n] = *(const f32x4*)(bias2 + bidx * 4096 + u.pn * 256 + lc0 + bj * 128 + n * 4);
#pragma unroll
            for (int ai = 0; ai < 2; ++ai)
#pragma unroll
                for (int m = 0; m < 4; ++m) { const int row = row0 + ai * 128 + m * 16;
#pragma unroll
                    for (int bj = 0; bj < 2; ++bj) { f32x4 v0 = acc[ai][bj][m][0] * rs[ai][m] + bv[bj][0], v1 = acc[ai][bj][m][1] * rs[ai][m] + bv[bj][1];
#pragma unroll
                        for (int e = 0; e < 4; ++e) { const float t0 = fmaxf(v0[e], 0.f), t1 = fmaxf(v1[e], 0.f); v0[e] = t0 * t0; v1[e] = t1 * t1; }
                        *(u32x4*)(dst + (size_t)row * 4096 + u.pn * 256 + lc0 + bj * 128) = PK8(v0, v1); } }
        } break;
        }
    }
};

DI void gemm_phase(LAS unsigned char* lds, const Sched& S_, const Epi& E) {
    Sched S = S_; asm volatile("" : "+s"(S.c));
    const int tid = tid_opaque(), wid = __builtin_amdgcn_readfirstlane(tid >> 6), lane = tid & 63, wr = wid >> 2, wc = wid & 3, fr = lane & 15, fq = lane >> 4;
    int sR[2], sRb[2], sC[2];
#pragma unroll
    for (int i = 0; i < 2; ++i) { int R, C; stage_rc(tid * 16 + i * 8192, R, C); sR[i] = R; sRb[i] = (R & ~31) + perm32(R & 31); sC[i] = C * 2; }
    const size_t kstep = (size_t)(BK * 2);
    const unsigned ldsw = (unsigned)wid * 1024u;
    const int aoff = lds_byte(wr * 64 + fr, fq * 8), boff = lds_byte(wc * 32 + fr, fq * 8);
#define PG8_SA(b, h) (((b) * 2 + (h)) * HTB)
#define PG8_SB(b, h) ((4 + (b) * 2 + (h)) * HTB)
#define PG8_STAGE_(RR, bufoff, gbase, ld) do { _Pragma("unroll") for (int _i = 0; _i < 2; ++_i) \
        __builtin_amdgcn_global_load_lds((const unsigned*)((const char*)(gbase) + (unsigned)(RR[_i] * (ld) + sC[_i])), (LAS unsigned*)(lds + (bufoff) + ldsw + _i * 8192), 16, 0, 0); } while (0)
#define PG8_STAGE(bufoff, gbase, ld) do { if ((bufoff) >= 4 * HTB) PG8_STAGE_(sRb, bufoff, gbase, ld); else PG8_STAGE_(sR, bufoff, gbase, ld); } while (0)
#define PG8_LDA(dst, b, h) do { _Pragma("unroll") for (int m = 0; m < 4; ++m) _Pragma("unroll") for (int k = 0; k < 2; ++k) dst[m][k] = *(const LAS bf16x8*)(lds + PG8_SA(b, h) + aoff + m * 2048 + k * 1024); } while (0)
#define PG8_LDB(dst, b, h) do { _Pragma("unroll") for (int n = 0; n < 2; ++n) _Pragma("unroll") for (int k = 0; k < 2; ++k) dst[n][k] = *(const LAS bf16x8*)(lds + PG8_SB(b, h) + boff + n * 2048 + k * 1024); } while (0)
#define PG8_MMA(ai, bj, At, Bt) do { __builtin_amdgcn_s_setprio(1); _Pragma("unroll") for (int m = 0; m < 4; ++m) _Pragma("unroll") for (int n = 0; n < 2; ++n) _Pragma("unroll") for (int k = 0; k < 2; ++k) \
        acc[ai][bj][m][n] = __builtin_amdgcn_mfma_f32_16x16x32_bf16(Bt[n][k], At[m][k], acc[ai][bj][m][n], 0, 0, 0); __builtin_amdgcn_s_setprio(0); } while (0)
#define PG8_WAIT_V(n) asm volatile("s_waitcnt vmcnt(" #n ")" ::: "memory")
#define PG8_WAIT_L(n) asm volatile("s_waitcnt lgkmcnt(" #n ")" ::: "memory")
#define PG8_BAR __builtin_amdgcn_s_barrier()
#define PG8_SCHED __builtin_amdgcn_sched_barrier(0)
    Unit cur, nxt; int ui = 0;
    if (!S.next(0, cur)) return;
    f32x4 acc[2][2][4][2];
#pragma unroll
    for (int a = 0; a < 2; ++a)
#pragma unroll
        for (int b = 0; b < 2; ++b)
#pragma unroll
            for (int m = 0; m < 4; ++m)
#pragma unroll
                for (int n = 0; n < 2; ++n) acc[a][b][m][n] = (f32x4){0.f, 0.f, 0.f, 0.f};
    bf16x8 At[4][2], B0[2][2], B1[2][2];
    const char* cA = cur.A; const char* cB = cur.B; int clda = cur.lda, cldb = cur.ldb;
    {
        const size_t hA = (size_t)HALF * clda, hB = (size_t)HALF * cldb;
        PG8_STAGE(PG8_SB(0, 0), cB, cldb); PG8_STAGE(PG8_SB(0, 1), cB + hB, cldb); PG8_STAGE(PG8_SA(0, 0), cA, clda); PG8_STAGE(PG8_SA(0, 1), cA + hA, clda);
        if (wr == 1) PG8_BAR;
        PG8_WAIT_V(2); PG8_BAR;
        PG8_STAGE(PG8_SB(1, 0), cB + kstep, cldb); PG8_STAGE(PG8_SA(1, 0), cA + kstep, clda); PG8_STAGE(PG8_SB(1, 1), cB + hB + kstep, cldb);
        PG8_WAIT_V(6); PG8_BAR;
    }
    for (;;) {
        const bool has_next = S.next(ui + 1, nxt);
        const char* nA = has_next ? nxt.A : cA; const char* nB = has_next ? nxt.B : cB;
        const int nlda = has_next ? nxt.lda : clda, nldb = has_next ? nxt.ldb : cldb;
        const int nt = cur.nt;
        const size_t hA = (size_t)HALF * clda, hB = (size_t)HALF * cldb, nhA = (size_t)HALF * nlda, nhB = (size_t)HALF * nldb;
        for (int t = 0; t < nt; t += 2) {
            const bool last = (t == nt - 2);
            const char* a1 = cA + (size_t)(t + 1) * kstep;
            const char* a2 = last ? nA : cA + (size_t)(t + 2) * kstep; const char* b2 = last ? nB : cB + (size_t)(t + 2) * kstep;
            const char* a3 = a2 + kstep; const char* b3 = b2 + kstep;
            const int l2a = last ? nlda : clda, l2b = last ? nldb : cldb; const size_t h2a = last ? nhA : hA, h2b = last ? nhB : hB;
            PG8_LDB(B0, 0, 0); PG8_LDB(B1, 0, 1); PG8_SCHED; PG8_LDA(At, 0, 0); PG8_STAGE(PG8_SA(1, 1), a1 + hA, clda);
            PG8_WAIT_V(8); PG8_WAIT_L(0); PG8_BAR; PG8_MMA(0, 0, At, B0); PG8_MMA(0, 1, At, B1); PG8_BAR; PG8_SCHED;
            PG8_LDA(At, 0, 1); PG8_STAGE(PG8_SB(0, 0), b2, l2b); PG8_STAGE(PG8_SB(0, 1), b2 + h2b, l2b); PG8_STAGE(PG8_SA(0, 0), a2, l2a);
            PG8_WAIT_V(8); PG8_WAIT_L(0); PG8_BAR; PG8_MMA(1, 0, At, B0); PG8_MMA(1, 1, At, B1); PG8_BAR; PG8_SCHED;
            PG8_LDB(B0, 1, 0); PG8_LDB(B1, 1, 1); PG8_SCHED; PG8_LDA(At, 1, 0); PG8_STAGE(PG8_SA(0, 1), a2 + h2a, l2a);
            PG8_WAIT_V(8); PG8_WAIT_L(0); PG8_BAR; PG8_MMA(0, 0, At, B0); PG8_MMA(0, 1, At, B1); PG8_BAR; PG8_SCHED;
            PG8_LDA(At, 1, 1); PG8_STAGE(PG8_SB(1, 0), b3, l2b); PG8_STAGE(PG8_SB(1, 1), b3 + h2b, l2b); PG8_STAGE(PG8_SA(1, 0), a3, l2a);
            PG8_WAIT_V(8); PG8_WAIT_L(0); PG8_BAR; PG8_MMA(1, 0, At, B0); PG8_MMA(1, 1, At, B1); PG8_BAR; PG8_SCHED;
        }
        if (wr == 0) PG8_BAR;
        E(acc, cur, wr, wc, fr, fq, tid, lds);
        if (!has_next) break;
#pragma unroll
        for (int a = 0; a < 2; ++a)
#pragma unroll
            for (int b = 0; b < 2; ++b)
#pragma unroll
                for (int m = 0; m < 4; ++m)
#pragma unroll
                    for (int n = 0; n < 2; ++n) acc[a][b][m][n] = (f32x4){0.f, 0.f, 0.f, 0.f};
        cur = nxt; cA = nA; cB = nB; clda = nlda; cldb = nldb; ++ui;
        if (wr == 1) PG8_BAR;
    }
    PG8_WAIT_V(0);
    PG8_BAR;
#undef PG8_SA
#undef PG8_SB
#undef PG8_STAGE
#undef PG8_STAGE_
#undef PG8_LDA
#undef PG8_LDB
#undef PG8_MMA
#undef PG8_WAIT_V
#undef PG8_WAIT_L
#undef PG8_BAR
#undef PG8_SCHED
}
}

#define MFMA32(a, b, c) __builtin_amdgcn_mfma_f32_32x32x16_bf16((a), (b), (c), 0, 0, 0)
DI int crow(int i, int h) { return (i & 3) + 8 * (i >> 2) + 4 * h; }
typedef short v4i16_t __attribute__((ext_vector_type(4)));
DI s16x4 tr_read(const LAS unsigned char* p) { return __builtin_bit_cast(s16x4, __builtin_amdgcn_ds_read_tr16_b64_v4i16((LAS v4i16_t*)p)); }
DI float swap_max(float m) { auto rr = __builtin_amdgcn_permlane32_swap(__float_as_uint(m), __float_as_uint(m), false, false); return fmaxf(__uint_as_float(rr[0]), __uint_as_float(rr[1])); }
DI float swap_sum(float m) { auto rr = __builtin_amdgcn_permlane32_swap(__float_as_uint(m), __float_as_uint(m), false, false); return __uint_as_float(rr[0]) + __uint_as_float(rr[1]); }
DI bf16x8 pack8(const f32x16& x, int s) {
    u32x4 p; p[0] = pk2(x[8 * s], x[8 * s + 1]); p[1] = pk2(x[8 * s + 2], x[8 * s + 3]); p[2] = pk2(x[8 * s + 4], x[8 * s + 5]); p[3] = pk2(x[8 * s + 6], x[8 * s + 7]);
    return __builtin_bit_cast(bf16x8, p);
}

DI float max3f(float a, float b, float c) { float r; asm("v_max3_f32 %0, %1, %2, %3" : "=v"(r) : "v"(a), "v"(b), "v"(c)); return r; }
DI float max2f(float a, float b) { float r; asm("v_max_f32_e32 %0, %1, %2" : "=v"(r) : "v"(a), "v"(b)); return r; }
DI float rowmax32(const f32x16& p0, const f32x16& p1) {
    float a = max3f(p0[0], p0[1], p1[0]), b = max3f(p0[2], p0[3], p1[1]); a = max3f(a, p1[2], p1[3]);
#pragma unroll
    for (int r = 4; r < 16; r += 4) { a = max3f(a, p0[r], p0[r + 1]); b = max3f(b, p0[r + 2], p0[r + 3]); a = max3f(a, p1[r], p1[r + 1]); b = max3f(b, p1[r + 2], p1[r + 3]); }
    const float m = max2f(a, b);
    auto rr = __builtin_amdgcn_permlane32_swap(__float_as_uint(m), __float_as_uint(m), false, false);
    return max2f(__uint_as_float(rr[0]), __uint_as_float(rr[1]));
}
constexpr int AT_K0 = 0, AT_K1 = 16384, AT_V0 = 32768, AT_V1 = 49152, AT_SEL = 65536, AT_MISC = 66560 + 1024, AT_FLAG = 66560 + 2048;
constexpr int VP = 144;

template <int MODE>
DI void attn_unit(unsigned char* ws, int b, int h, int qb, LAS unsigned char* lds, bool do_store = true) {
    constexpr int DQK = MODE == 0 ? 96 : 64, NS = DQK / 16, KP = DQK * 2 + 16;
    constexpr int QPITCH = MODE == 0 ? 768 : 1536, KPITCH = MODE == 0 ? 1024 : 1536, OPITCH = MODE == 0 ? 512 : 1536;
    const bf16_t* Qb = (const bf16_t*)(ws + (MODE == 0 ? WS_QMLA : (MODE == 1 ? WS_SB : WS_MB)));
    const bf16_t* Kb = (const bf16_t*)(ws + (MODE == 0 ? WS_KVMLA : (MODE == 1 ? WS_SB : WS_MB)));
    bf16_t* Ob = (bf16_t*)(ws + (MODE == 0 ? WS_OMLA : (MODE == 1 ? WS_SB : WS_MB)));
    const bf16_t* KPEb = (const bf16_t*)(ws + WS_KPE);
    const int qcol = MODE == 0 ? h * 96 : h * 64, kcol = MODE == 0 ? h * 128 : 512 + h * 64, vcol = MODE == 0 ? h * 128 + 64 : 1024 + h * 64, ocol = h * 64;
    const int tid = tid_opaque(), lane = tid & 63, w = __builtin_amdgcn_readfirstlane(tid >> 6), r = lane & 31, hh = lane >> 5;
    const int q0 = qb * 256; const long rowbase = (long)b * SEQ;
    const int qg = q0 + 32 * w + r;
    bf16x8 qf[NS];
    { const bf16_t* qrow = Qb + (size_t)(rowbase + qg) * QPITCH + qcol + 8 * hh;
#pragma unroll
      for (int s = 0; s < NS; ++s) qf[s] = *(const bf16x8*)(qrow + 16 * s); }
    unsigned mysel = 0;
    if (MODE == 2) {
        if (tid < 256) {
            const bf16_t* qr = Qb + (size_t)(rowbase + q0 + tid) * QPITCH + qcol;
            float qv[64];
#pragma unroll
            for (int c8 = 0; c8 < 8; ++c8) { const u32x4 u = *(const u32x4*)(qr + c8 * 8);
#pragma unroll
                for (int e = 0; e < 4; ++e) { qv[c8 * 8 + 2 * e] = bf_lo(u[e]); qv[c8 * 8 + 2 * e + 1] = bf_hi(u[e]); } }
            const float* km = (const float*)(ws + WS_KMEAN) + (size_t)((b * 8 + h) * 16) * 64;
            float v0 = -INFINITY, v1 = -INFINITY, v2 = -INFINITY; int i0 = -1, i1 = -1, i2 = -1;
            for (int n = 0; n < qb; ++n) { float d = 0.f;
#pragma unroll
                for (int e = 0; e < 64; ++e) d += qv[e] * km[n * 64 + e];
                if (d > v0) { v2 = v1; i2 = i1; v1 = v0; i1 = i0; v0 = d; i0 = n; }
                else if (d > v1) { v2 = v1; i2 = i1; v1 = d; i1 = n; }
                else if (d > v2) { v2 = d; i2 = n; } }
            unsigned mk = 0; if (i0 >= 0) mk |= 1u << i0; if (i1 >= 0) mk |= 1u << i1; if (i2 >= 0) mk |= 1u << i2;
            *(LAS unsigned*)(lds + AT_SEL + tid * 4) = mk;
        }
        __syncthreads();
        mysel = *(LAS unsigned*)(lds + AT_SEL + (32 * w + r) * 4);
    }
    const int kkey = tid >> 3, kch = tid & 7, pkey = (tid & 255) >> 2, pch = tid & 3;
    u32x4 kr[2], vr[2], pr[2];
    pr[0] = (u32x4){0u, 0u, 0u, 0u}; pr[1] = pr[0];
#define AT_LOADG(kt, R) do { const size_t krow_ = (size_t)(rowbase + (kt) * 64 + kkey); \
        kr[R] = *(const u32x4*)(Kb + krow_ * KPITCH + kcol + kch * 8); vr[R] = *(const u32x4*)(Kb + krow_ * KPITCH + vcol + kch * 8); \
        if (MODE == 0 && tid < 256) pr[R] = *(const u32x4*)(KPEb + (size_t)(rowbase + (kt) * 64 + pkey) * 32 + pch * 8); } while (0)
#define AT_STORE(bf, R) do { *(LAS u32x4*)(lds + ((bf) ? AT_K1 : AT_K0) + kkey * KP + kch * 16) = kr[R]; *(LAS u32x4*)(lds + ((bf) ? AT_V1 : AT_V0) + kkey * VP + kch * 16) = vr[R]; \
        if (MODE == 0 && tid < 256) *(LAS u32x4*)(lds + ((bf) ? AT_K1 : AT_K0) + pkey * KP + 128 + pch * 16) = pr[R]; } while (0)
    const int kt_hi = qb * 4 + 3;
    AT_LOADG(kt_hi, 0); AT_LOADG(kt_hi - 1, 1); AT_STORE(0, 0);
    __syncthreads();
    f32x16 o0, o1;
#pragma unroll
    for (int i = 0; i < 16; ++i) { o0[i] = 0.f; o1[i] = 0.f; }
    float carry = (MODE == 1) ? 1.f : 0.f; bool first = true;
    f32x16 lacc;
#pragma unroll
    for (int i = 0; i < 16; ++i) lacc[i] = 0.f;
    float refv = 0.f;
    const short kx0 = (hh == 0) ? (short)0xBF80 : (short)0;
    const bf16x8 kx = {kx0, 0, 0, 0, 0, 0, 0, 0};
    bf16x8 qx = {0, 0, 0, 0, 0, 0, 0, 0};
    const bf16x8 qbig = {(hh == 0) ? (short)0x7149 : (short)0, 0, 0, 0, 0, 0, 0, 0};
    f32x16 zero16;
#pragma unroll
    for (int i = 0; i < 16; ++i) zero16[i] = 0.f;
    const bf16x8 ones = {(short)0x3F80, (short)0x3F80, (short)0x3F80, (short)0x3F80, (short)0x3F80, (short)0x3F80, (short)0x3F80, (short)0x3F80};
    const int i16 = lane & 15, tq = i16 >> 2, tp = i16 & 3, blk = (lane >> 4) & 1;
    const int voff = (4 * hh + tq) * VP + (16 * blk + 4 * tp) * 2;
    const int qmin_w = q0 + 32 * w, qmax_w = qmin_w + 31;
    bool wfin = false, fin = false;
    int kt = kt_hi;
    for (;;) {
#pragma unroll
      for (int half = 0; half < 2; ++half) {
        if (kt >= 2) AT_LOADG(kt - 2, half);
        if (kt * 64 <= qmax_w && !wfin) {
            const LAS unsigned char* kb = lds + (half ? AT_K1 : AT_K0) + r * KP + hh * 16;
            f32x16 p0, p1;
#pragma unroll
            for (int s = 0; s < NS; ++s) {
                const bf16x8 k0 = *(const LAS bf16x8*)(kb + s * 32), k1 = *(const LAS bf16x8*)(kb + 32 * KP + s * 32);
                if (s == 0) { p0 = MFMA32(k0, qf[s], zero16); p1 = MFMA32(k1, qf[s], zero16); }
                else { p0 = MFMA32(k0, qf[s], p0); p1 = MFMA32(k1, qf[s], p1); }
            }
            if (MODE != 1) {
                bf16x8 qe = qx;
                if (MODE == 2) { const int nbk = kt >> 2; const bool dead = (nbk < qb) && !((mysel >> nbk) & 1u); qe = dead ? qbig : qx; }
                p0 = MFMA32(kx, qe, p0); p1 = MFMA32(kx, qe, p1);
            }
            bf16x8 vaf[4][2];
            { const LAS unsigned char* vb = lds + (half ? AT_V1 : AT_V0) + voff;
#pragma unroll
              for (int f = 0; f < 4; ++f) { const LAS unsigned char* vp = vb + (16 * f) * VP;
                  { const s16x4 lo = tr_read(vp), hi = tr_read(vp + 8 * VP); vaf[f][0] = __builtin_shufflevector(lo, hi, 0, 1, 2, 3, 4, 5, 6, 7); }
                  { const s16x4 lo = tr_read(vp + 64), hi = tr_read(vp + 8 * VP + 64); vaf[f][1] = __builtin_shufflevector(lo, hi, 0, 1, 2, 3, 4, 5, 6, 7); } } }
#define AT_PV(f, P, S2) do { const bf16x8 pf_ = pack8(P, S2); o0 = MFMA32(vaf[f][0], pf_, o0); o1 = MFMA32(vaf[f][1], pf_, o1); if (MODE != 1) lacc = MFMA32(ones, pf_, lacc); } while (0)
            const bool needmask = (kt * 64 + 63 >= qmin_w);
            const int kbase = kt * 64;
            if (MODE == 1) {
                f32x16 k0v, k1v;
#pragma unroll
                for (int i = 0; i < 16; ++i) {
                    { const float z = p0[i]; const float e = fast_exp2(-fabsf(z)), rc = __builtin_amdgcn_rcpf(1.f + e), t = e * rc; float bt = z >= 0.f ? rc : t, kp = z >= 0.f ? t : rc;
                      if (needmask && !(kbase + crow(i, hh) < qg)) { bt = 0.f; kp = 1.f; } p0[i] = bt; k0v[i] = kp; }
                    { const float z = p1[i]; const float e = fast_exp2(-fabsf(z)), rc = __builtin_amdgcn_rcpf(1.f + e), t = e * rc; float bt = z >= 0.f ? rc : t, kp = z >= 0.f ? t : rc;
                      if (needmask && !(kbase + 32 + crow(i, hh) < qg)) { bt = 0.f; kp = 1.f; } p1[i] = bt; k1v[i] = kp; }
                }
                float run = carry;
#pragma unroll
                for (int u = 7; u >= 0; --u) {
                    const int g = u & 3;
                    float gs = (u >= 4) ? ((k1v[4 * g] * k1v[4 * g + 1]) * (k1v[4 * g + 2] * k1v[4 * g + 3])) : ((k0v[4 * g] * k0v[4 * g + 1]) * (k0v[4 * g + 2] * k0v[4 * g + 3]));
                    auto rr = __builtin_amdgcn_permlane32_swap(__float_as_uint(gs), __float_as_uint(gs), false, false);
                    const float glo = __uint_as_float(rr[0]), ghi = __uint_as_float(rr[1]);
                    float a = run * (hh == 0 ? ghi : 1.f);
#pragma unroll
                    for (int jj = 3; jj >= 0; --jj) {
                        if (u >= 4) { const float bt = p1[4 * g + jj]; p1[4 * g + jj] = bt * a; a *= k1v[4 * g + jj]; }
                        else { const float bt = p0[4 * g + jj]; p0[4 * g + jj] = bt * a; a *= k0v[4 * g + jj]; }
                    }
                    run *= glo * ghi;
                    if (u == 6) AT_PV(3, p1, 1); else if (u == 4) AT_PV(2, p1, 0); else if (u == 2) AT_PV(1, p0, 1); else if (u == 0) AT_PV(0, p0, 0);
                }
                carry = run;
                wfin = __all(carry < 1.2e-38f);
            } else {
                if (needmask) {
#pragma unroll
                    for (int i = 0; i < 16; ++i) { if (kbase + crow(i, hh) > qg) p0[i] = -INFINITY; if (kbase + 32 + crow(i, hh) > qg) p1[i] = -INFINITY; }
                }
                const float mt = rowmax32(p0, p1);
                if (first || __any(mt > 8.f)) {
                    const float delta = first ? (mt > -1e30f ? mt : 0.f) : (mt > 8.f ? mt : 0.f);
                    const unsigned nb16 = pk2(refv + delta, 0.f) & 0xffffu; const float nref = __uint_as_float(nb16 << 16);
                    const float d2 = nref - refv; const float sc = fast_exp2(-d2);
#pragma unroll
                    for (int i = 0; i < 16; ++i) { p0[i] -= d2; p1[i] -= d2; o0[i] *= sc; o1[i] *= sc; lacc[i] *= sc; }
                    refv = nref; qx[0] = (hh == 0) ? (short)nb16 : (short)0;
                    first = false;
                }
#pragma unroll
                for (int i = 0; i < 8; ++i) p0[i] = fast_exp2(p0[i]);
                AT_PV(0, p0, 0);
#pragma unroll
                for (int i = 8; i < 16; ++i) p0[i] = fast_exp2(p0[i]);
                AT_PV(1, p0, 1);
#pragma unroll
                for (int i = 0; i < 8; ++i) p1[i] = fast_exp2(p1[i]);
                AT_PV(2, p1, 0);
#pragma unroll
                for (int i = 8; i < 16; ++i) p1[i] = fast_exp2(p1[i]);
                AT_PV(3, p1, 1);
            }
#undef AT_PV
        }
        if (kt >= 1) AT_STORE(half ^ 1, half ^ 1);
        if (MODE == 1 && lane == 0) *(LAS unsigned*)(lds + AT_FLAG + half * 32 + w * 4) = wfin ? 1u : 0u;
        asm volatile("s_waitcnt lgkmcnt(0)" ::: "memory"); __builtin_amdgcn_s_barrier(); asm volatile("" ::: "memory");
        if (MODE == 1) { const u32x4 fa = *(const LAS u32x4*)(lds + AT_FLAG + half * 32), fb = *(const LAS u32x4*)(lds + AT_FLAG + half * 32 + 16);
            if ((fa.x & fa.y & fa.z & fa.w & fb.x & fb.y & fb.z & fb.w) != 0u) { fin = true; break; } }
        if (kt == 0) { fin = true; break; }
        --kt;
      }
      if (fin) break;
    }
    if (MODE != 1) { const float inv = 1.f / lacc[0];
#pragma unroll
        for (int i = 0; i < 16; ++i) { o0[i] *= inv; o1[i] *= inv; } }
    bf16_t* orow = Ob + (size_t)(rowbase + qg) * OPITCH + ocol + 4 * hh;
    if (do_store)
#pragma unroll
    for (int g = 0; g < 4; ++g) {
        u32x2 a, c; a.x = pk2(o0[4 * g], o0[4 * g + 1]); a.y = pk2(o0[4 * g + 2], o0[4 * g + 3]); c.x = pk2(o1[4 * g], o1[4 * g + 1]); c.y = pk2(o1[4 * g + 2], o1[4 * g + 3]);
        *(u32x2*)(orow + 8 * g) = a; *(u32x2*)(orow + 32 + 8 * g) = c;
    }
#undef AT_LOADG
#undef AT_STORE
}

DI void attn_phase(unsigned char* ws, LAS unsigned char* lds, unsigned* ctr, bool never) {
    const int tid = tid_opaque();
    for (;;) {
        __syncthreads();
        if (tid == 0) *(LAS int*)(lds + AT_MISC) = (int)atomicAdd(ctr, 1u);
        __syncthreads();
        const int u = *(LAS int*)(lds + AT_MISC);
        if (u >= 3072) break;
        if (u < 2048) { const int qb = 15 - (u >> 7), rem = u & 127, ty = rem >> 6, bh = rem & 63;
#ifdef PROBE_ATT2
            if (ty == 0) { attn_unit<0>(ws, bh >> 3, bh & 7, qb, lds, never); __syncthreads(); } else { attn_unit<2>(ws, bh >> 3, bh & 7, qb, lds, never); __syncthreads(); }
#endif
            if (ty == 0) attn_unit<0>(ws, bh >> 3, bh & 7, qb, lds); else attn_unit<2>(ws, bh >> 3, bh & 7, qb, lds); }
        else { const int v = u - 2048, qb = 15 - (v >> 6), bh = v & 63;
#ifdef PROBE_ATT2
            attn_unit<1>(ws, bh >> 3, bh & 7, qb, lds, never); __syncthreads();
#endif
            attn_unit<1>(ws, bh >> 3, bh & 7, qb, lds); }
    }
}

DI void cvt_T(const float* in, int K, int N, int ldin, bf16_t* out, int ldout, const float* gk, LAS float* tile, int& off) {
    const int tid = tid_opaque(), G = gridDim.x, kts = K / 64, nts = N / 32, ntile = kts * nts;
    for (int t = (int)((blockIdx.x + G - (off % G)) % G); t < ntile; t += G) {
        const int k0 = (t % kts) * 64, n0 = (t / kts) * 32;
#pragma unroll
        for (int i = 0; i < 4; ++i) { const int kl = (tid >> 5) + 16 * i, nl = tid & 31; float v = in[(size_t)(k0 + kl) * ldin + n0 + nl]; if (gk) v *= gk[k0 + kl]; tile[kl * 33 + nl] = v; }
        __syncthreads();
#pragma unroll
        for (int i = 0; i < 2; ++i) { const int nl = (tid >> 5) + 16 * i, kp = tid & 31;
            *(unsigned*)(out + (size_t)(n0 + nl) * ldout + k0 + 2 * kp) = pk2(tile[(2 * kp) * 33 + nl], tile[(2 * kp + 1) * 33 + nl]); }
        __syncthreads();
    }
    off += ntile;
}

DI void phase_bias(const Params& p, int l, LAS unsigned char* lds) {
    const int tid = tid_opaque(), lane = tid & 63, w = tid >> 6; unsigned char* ws = p.ws;
    LAS float* sh = (LAS float*)lds;
    LAS float* red = (LAS float*)(lds + 65536);
    const float* modl = (const float*)(ws + WS_MOD) + (size_t)l * 8 * 6144;
    bool staged = false;
    for (int it = (int)((blockIdx.x + 128) % gridDim.x); it < 177; it += gridDim.x) {
        if (!staged) { for (int i = tid; i < 8192; i += NTHREADS) { sh[i] = modl[(i >> 10) * 6144 + (i & 1023)]; sh[8192 + i] = modl[(i >> 10) * 6144 + 3072 + (i & 1023)]; } staged = true; }
        __syncthreads();
        const bool isin = it < 113; const int n = (isin ? it : it - 113) * 64 + lane; const int ld = isin ? 7200 : 4096; const bool valid = n < ld;
        const float* wa = (isin ? p.w_in + (size_t)l * 1024 * 7200 : p.w_ff1 + (size_t)l * 1024 * 4096) + (valid ? n : 0);
        const LAS float* shp = sh + (isin ? 0 : 8192);
        float a[8];
#pragma unroll
        for (int b = 0; b < 8; ++b) a[b] = 0.f;
#pragma unroll 16
        for (int k = w * 128; k < w * 128 + 128; ++k) { const float wv = wa[(size_t)k * ld];
#pragma unroll
            for (int b = 0; b < 8; ++b) a[b] += shp[b * 1024 + k] * wv; }
#pragma unroll
        for (int b = 0; b < 8; ++b) red[(w * 8 + b) * 64 + lane] = a[b];
        __syncthreads();
        { const int b = w; float sacc = 0.f;
#pragma unroll
          for (int ww = 0; ww < 8; ++ww) sacc += red[(ww * 8 + b) * 64 + lane];
          if (valid) { if (isin) ((float*)(ws + WS_BIAS1))[(size_t)(l * 8 + b) * NWIN + (n < 1056 ? n : n + 224)] = sacc; else ((float*)(ws + WS_BIAS2))[(size_t)(l * 8 + b) * 4096 + n] = sacc; } }
        __syncthreads();
    }
}

DI void phase_convert(const Params& p, int l, LAS unsigned char* lds) {
    LAS float* tile = (LAS float*)lds; unsigned char* ws = p.ws; int off = 0;
    const float* win = p.w_in + (size_t)l * 1024 * 7200;
    cvt_T(win, 1024, 1056, 7200, (bf16_t*)(ws + W_IN), 1024, nullptr, tile, off);
    cvt_T(win + 1056, 1024, 6144, 7200, (bf16_t*)(ws + W_IN) + (size_t)1280 * 1024, 1024, nullptr, tile, off);
    { u32x4* z = (u32x4*)((bf16_t*)(ws + W_IN) + (size_t)1056 * 1024); const int n = 224 * 1024 * 2 / 16;
      for (int i = blockIdx.x * NTHREADS + tid_opaque(); i < n; i += gridDim.x * NTHREADS) z[i] = (u32x4){0u, 0u, 0u, 0u}; }
    cvt_T(p.w_uq + (size_t)l * 768 * 768, 768, 768, 768, (bf16_t*)(ws + W_UQ), 768, p.q_norm_g + l * 768, tile, off);
    cvt_T(p.w_ukv + (size_t)l * 256 * 1024, 256, 1024, 1024, (bf16_t*)(ws + W_UKV), 256, p.kv_norm_g + l * 256, tile, off);
    cvt_T(p.w_o_mla + (size_t)l * 512 * 1024, 512, 1024, 1024, (bf16_t*)(ws + W_O), 512, nullptr, tile, off);
    cvt_T(p.w_o_sb + (size_t)l * 512 * 1024, 512, 1024, 1024, (bf16_t*)(ws + W_O) + (size_t)1024 * 512, 512, nullptr, tile, off);
    cvt_T(p.w_o_moba + (size_t)l * 512 * 1024, 512, 1024, 1024, (bf16_t*)(ws + W_O) + (size_t)2048 * 512, 512, nullptr, tile, off);
    cvt_T(p.w_out + (size_t)l * 1024 * 1024, 1024, 1024, 1024, (bf16_t*)(ws + W_OUT), 1024, nullptr, tile, off);
    cvt_T(p.w_ff1 + (size_t)l * 1024 * 4096, 1024, 4096, 4096, (bf16_t*)(ws + W_FF1), 1024, nullptr, tile, off);
    cvt_T(p.w_ff2 + (size_t)l * 4096 * 1024, 4096, 1024, 1024, (bf16_t*)(ws + W_FF2), 4096, nullptr, tile, off);
}

DI void phase_pre(const float* xin, const float* g, const float* modl, bf16_t* hdn, float* ssq) {
    const int tid = tid_opaque(), lane = tid & 63, w = tid >> 6;
    for (int row = blockIdx.x * 16 + w * 2; row < T; row += gridDim.x * 16) {
        f32x4 v[2][4];
#pragma unroll
        for (int rr = 0; rr < 2; ++rr) { const f32x4* xr = (const f32x4*)(xin + (size_t)(row + rr) * 1024) + lane;
#pragma unroll
            for (int j = 0; j < 4; ++j) v[rr][j] = xr[64 * j]; }
#pragma unroll
        for (int rr = 0; rr < 2; ++rr) { float s = 0.f;
#pragma unroll
            for (int j = 0; j < 4; ++j) s += (v[rr][j][0] * v[rr][j][0] + v[rr][j][1] * v[rr][j][1]) + (v[rr][j][2] * v[rr][j][2] + v[rr][j][3] * v[rr][j][3]);
            s = wave_sum(s); if (lane < 16) ssq[(size_t)(row + rr) * 16 + lane] = lane == 0 ? s : 0.f;
            const float* mb = modl + ((row + rr) >> 12) * 6144 + 1024;
#pragma unroll
            for (int j = 0; j < 4; ++j) { const int col = 4 * (lane + 64 * j);
                const f32x4 gg = *(const f32x4*)(g + col), sc = *(const f32x4*)(mb + col);
                *(u32x2*)(hdn + (size_t)(row + rr) * 1024 + col) = pk4(v[rr][j] * gg * (sc + 1.f)); } }
    }
}
DI void phase_final(float* xo, const bf16_t* xb, const float* g, const float* ssq) {
    const int tid = tid_opaque();
    for (int i = blockIdx.x * NTHREADS + tid; i < T * 128; i += gridDim.x * NTHREADS) {
        const int row = i >> 7, col = (i & 127) * 8; const float rstd = 1.f / sqrtf(sum16(ssq + (size_t)row * 16) * (1.f / 1024.f) + EPS);
        const u32x4 u = *(const u32x4*)(xb + (size_t)row * 1024 + col); const f32x4 g0 = *(const f32x4*)(g + col), g1 = *(const f32x4*)(g + col + 4);
        f32x4 a = {bf_lo(u.x), bf_hi(u.x), bf_lo(u.y), bf_hi(u.y)}, b = {bf_lo(u.z), bf_hi(u.z), bf_lo(u.w), bf_hi(u.w)};
        *(f32x4*)(xo + (size_t)row * 1024 + col) = (a * rstd) * g0; *(f32x4*)(xo + (size_t)row * 1024 + col + 4) = (b * rstd) * g1;
    }
}

DI void phase0(const Params& p, LAS unsigned char* lds) {
    const int tid = tid_opaque(), lane = tid & 63, w = tid >> 6; unsigned char* ws = p.ws;
    if (blockIdx.x == 0 && tid < 64) ((unsigned*)(ws + WS_CTR))[tid] = 0u;
    LAS float* cs = (LAS float*)lds;
    LAS float* red = (LAS float*)(lds + 32768);
    bool staged = false;
    for (int it = blockIdx.x; it < 192; it += gridDim.x) {
        if (!staged) { for (int i = tid; i < 8192; i += NTHREADS) { const float cv = p.c[i]; cs[i] = cv / (1.f + __expf(-cv)); } staged = true; }
        __syncthreads();
        const int l = it / 96, n = (it % 96) * 64 + lane;
        const float* wa = p.w_ada + (size_t)l * 1024 * 6144 + n;
        float a[8];
#pragma unroll
        for (int b = 0; b < 8; ++b) a[b] = 0.f;
#pragma unroll 16
        for (int k = w * 128; k < w * 128 + 128; ++k) { const float wv = wa[(size_t)k * 6144];
#pragma unroll
            for (int b = 0; b < 8; ++b) a[b] += cs[b * 1024 + k] * wv; }
#pragma unroll
        for (int b = 0; b < 8; ++b) red[(w * 8 + b) * 64 + lane] = a[b];
        __syncthreads();
        { const int b = w; float s = p.b_ada[l * 6144 + n];
#pragma unroll
          for (int ww = 0; ww < 8; ++ww) s += red[(ww * 8 + b) * 64 + lane];
          ((float*)(ws + WS_MOD))[(size_t)(l * 8 + b) * 6144 + n] = s; }
        __syncthreads();
    }
    const float L2T = 18.931568569324174f;
    float* rm = (float*)(ws + WS_ROPEM); float* rb = (float*)(ws + WS_ROPEB);
    for (int i = blockIdx.x * NTHREADS + tid; i < T * 24; i += gridDim.x * NTHREADS) {
        const int tok = i / 24, j = i % 24; const float ps = (float)p.pos[tok];
        float inv; if (j < 16) inv = exp2f(-(float)j * (L2T / 16.f)); else inv = exp2f(-(float)(j - 16) * (L2T / 8.f));
        const float ang = ps * inv; const double rev = (double)ang * 0.15915494309189535; const float fr = (float)(rev - rint(rev));
        const float sn = __builtin_amdgcn_sinf(fr), cn = __builtin_amdgcn_cosf(fr);
        if (j < 16) { rm[(size_t)tok * 32 + j] = cn; rm[(size_t)tok * 32 + 16 + j] = sn; } else { rb[(size_t)tok * 16 + (j - 16)] = cn; rb[(size_t)tok * 16 + 8 + (j - 16)] = sn; }
    }
}

DI void phase_kmean(unsigned char* ws, LAS unsigned char* lds) {
    const int tid = tid_opaque(); LAS float* red = (LAS float*)lds;
    const bf16_t* mb = (const bf16_t*)(ws + WS_MB); float* km = (float*)(ws + WS_KMEAN);
    for (int it = blockIdx.x; it < 1024; it += gridDim.x) {
        const int b = it >> 7, h = (it >> 4) & 7, nb = it & 15, c8 = tid & 7, j0 = tid >> 3;
        float s[8];
#pragma unroll
        for (int e = 0; e < 8; ++e) s[e] = 0.f;
#pragma unroll
        for (int jj = 0; jj < 4; ++jj) { const size_t row = (size_t)b * SEQ + nb * 256 + j0 + 64 * jj; const u32x4 u = *(const u32x4*)(mb + row * 1536 + 512 + h * 64 + c8 * 8);
#pragma unroll
            for (int e = 0; e < 4; ++e) { s[2 * e] += bf_lo(u[e]); s[2 * e + 1] += bf_hi(u[e]); } }
#pragma unroll
        for (int e = 0; e < 8; ++e) red[j0 * 65 + c8 * 8 + e] = s[e];
        __syncthreads();
        if (tid < 64) { float t = 0.f; for (int j = 0; j < 64; ++j) t += red[j * 65 + tid]; km[(size_t)it * 64 + tid] = t * (1.f / 256.f); }
        __syncthreads();
    }
}

#define XB_TMO      128
#define XB_XCNT(j)  (256  + 64 * (j))
#define XB_XSUB(j)  (1280 + 64 * (j))
#define XB_XGEN(j)  (2304 + 64 * (j))
#define XB_TOP      3328
#define XB_TOPGEN   3392
#define XCD_BAR_WORDS 3456
#define XB_SPIN_CAP (1u << 22)
DI unsigned xb_ld(unsigned* p)              { return __hip_atomic_load(p, __ATOMIC_RELAXED, __HIP_MEMORY_SCOPE_AGENT); }
DI unsigned xb_add(unsigned* p, unsigned v) { return __hip_atomic_fetch_add(p, v, __ATOMIC_RELAXED, __HIP_MEMORY_SCOPE_AGENT); }
DI unsigned xb_xcc_id() { return (unsigned)__builtin_amdgcn_s_getreg((3 << 11) | 20) & 0xFu; }
#define XB_SPIN(cond, bar) do { unsigned _sp = 0; while (cond) { __builtin_amdgcn_s_sleep(1); \
    if ((++_sp & 255u) == 0u) { if (xb_ld(&(bar)[XB_TMO])) break; if (_sp > XB_SPIN_CAP) { atomicAdd(&(bar)[XB_TMO], 1u); break; } } } } while (0)
struct XcdBarrier { unsigned* bar; unsigned x; volatile LAS unsigned* st; };
DI XcdBarrier xcd_barrier_post(unsigned* bar, volatile LAS unsigned* st) {
    XcdBarrier b; b.bar = bar; b.x = xb_xcc_id(); b.st = st;
    if (threadIdx.x == 0) (void)xb_add(&bar[XB_XCNT(b.x)], 1u);
    return b;
}
DI void xcd_barrier_complete(unsigned* bar, unsigned x, unsigned& nloc, unsigned& nx) {
    const unsigned G = gridDim.x * gridDim.y * gridDim.z;
    unsigned sum, cnt, mine, sp = 0u;
    for (;;) {
        sum = 0u; cnt = 0u; mine = 0u;
#pragma unroll
        for (unsigned j = 0; j < 16; ++j) { const unsigned c = xb_ld(&bar[XB_XCNT(j)]); sum += c; cnt += (c > 0u) ? 1u : 0u; mine = (j == x) ? c : mine; }
        if (sum == G) break;
        __builtin_amdgcn_s_sleep(1);
        if ((++sp & 255u) == 0u) { if (xb_ld(&bar[XB_TMO])) break; if (sp > XB_SPIN_CAP) { atomicAdd(&bar[XB_TMO], 1u); break; } }
    }
    nloc = mine > 0u ? mine : 1u; nx = cnt > 0u ? cnt : 1u;
}
DI void xcd_barrier(const XcdBarrier& b) {
    asm volatile("s_waitcnt vmcnt(0)" ::: "memory");
    __syncthreads();
    if (threadIdx.x == 0) {
        unsigned* bar = b.bar;
        __builtin_amdgcn_s_waitcnt(0);
        unsigned nloc = b.st[0], nx = b.st[1];
        if (nloc == 0u) { xcd_barrier_complete(bar, b.x, nloc, nx); b.st[0] = nloc; b.st[1] = nx; }
        const unsigned old = xb_add(&bar[XB_XSUB(b.x)], 1u);
        const unsigned gen = old / nloc;
        if (old + 1u == (gen + 1u) * nloc) {
            __builtin_amdgcn_fence(__ATOMIC_RELEASE, "agent");
            asm volatile("s_waitcnt vmcnt(0)" ::: "memory");
            const unsigned og = xb_add(&bar[XB_TOP], 1u);
            const unsigned tg = og / nx;
            if (og + 1u == (tg + 1u) * nx) xb_add(&bar[XB_TOPGEN], 1u);
            else XB_SPIN(xb_ld(&bar[XB_TOPGEN]) == tg, bar);
            __builtin_amdgcn_fence(__ATOMIC_ACQUIRE, "agent");
            xb_add(&bar[XB_XGEN(b.x)], 1u);
            asm volatile("s_waitcnt vmcnt(0)" ::: "memory");
        } else {
            XB_SPIN(xb_ld(&bar[XB_XGEN(b.x)]) == gen, bar);
            __builtin_amdgcn_fence(__ATOMIC_ACQUIRE, "agent");
            asm volatile("s_waitcnt vmcnt(0)" ::: "memory");
        }
    }
    __syncthreads();
}
constexpr size_t WS_BAR = 4096;
constexpr int NPHASE = 18;
__global__ void __launch_bounds__(NTHREADS, 2) fwd_kernel(Params p_unused) {
#if defined(__HIP_DEVICE_COMPILE__)
    extern __shared__ __attribute__((aligned(16))) unsigned char lds_raw[];
    LAS unsigned char* lds = (LAS unsigned char*)lds_raw;
    cg::grid_group grid = cg::this_grid();
    PP pk = (PP)__builtin_amdgcn_kernarg_segment_ptr();
    const int ph_lo = pk->ph_lo, ph_hi = pk->ph_hi;
    volatile LAS unsigned* xst = (volatile LAS unsigned*)(lds + 131072 + 4096);
    if (threadIdx.x == 0) { xst[0] = 0u; xst[1] = 0u; }
    __syncthreads();
    const XcdBarrier xbar = xcd_barrier_post((unsigned*)(pk->ws + WS_BAR), xst);
    for (int ph = ph_lo; ph < ph_hi; ++ph) {
        if (ph > ph_lo) { if (ph == ph_lo + 1) grid.sync(); else xcd_barrier(xbar); }
        PP pp = pk; asm volatile("" : "+s"(pp));
        if (ph == 0) { const Params p = *pp; phase0(p, lds); continue; }
        if (ph == NPHASE - 1) { phase_final(pp->out, (const bf16_t*)(pp->ws + WS_HDN), pp->final_g, (const float*)(pp->ws + WS_SSQXP) + (size_t)2 * T * 16); continue; }
        const int l = (ph - 1) >> 3, s = (ph - 1) & 7;
        if (s == 0) {
            const Params p = *pp; unsigned char* ws = p.ws;
            phase_convert(p, l, lds);
            __syncthreads();
            phase_bias(p, l, lds);
            if (l == 0) phase_pre(p.x, p.norm1_g, (const float*)(ws + WS_MOD), (bf16_t*)(ws + WS_HDN), (float*)(ws + WS_SSQXP));
        } else if (s == 3) {
            unsigned char* ws = pp->ws;
            attn_phase(ws, lds, (unsigned*)(ws + WS_CTR) + l, ph_hi == 12345);
        } else {
            unsigned char* ws = pp->ws;
            pg8::Sched S; S.G = gridDim.x; S.c = blockIdx.x; S.ws = (const char*)ws;
            pg8::Epi E; E.pp = pk; E.l = l;
            S.mode = s == 1 ? pg8::M_PROJ : (s == 2 ? pg8::M_UP : (s == 4 ? pg8::M_MERGE : (s == 5 ? pg8::M_OUT : (s == 6 ? pg8::M_FF1 : pg8::M_FF2))));
            pg8::gemm_phase(lds, S, E);
            if (s == 2) phase_kmean(ws, lds);
        }
    }
#endif
}

extern "C" void kernel_launch(void* const* d_in, const int* in_sizes, int n_in, void* d_out, int out_size, void* d_ws, size_t ws_size, hipStream_t stream) {
    static int grid = 0;
    if (grid == 0) {
        if (n_in != 19 || in_sizes[0] != T * DM || out_size != T * DM || ws_size < WS_END) {
            fprintf(stderr, "kernel_launch: unexpected shapes/workspace (n_in %d, in0 %d, out %d, ws %zu; need ws >= %zu); nothing launched\n", n_in, n_in > 0 ? in_sizes[0] : -1, out_size, ws_size, (size_t)WS_END);
            grid = -1; return; }
        int dev = 0, cus = 0, per_cu = 0;
        hipGetDevice(&dev); hipDeviceGetAttribute(&cus, hipDeviceAttributeMultiprocessorCount, dev);
        if (hipFuncSetAttribute((const void*)fwd_kernel, hipFuncAttributeMaxDynamicSharedMemorySize, LDS_BYTES) != hipSuccess) { fprintf(stderr, "kernel_launch: hipFuncSetAttribute failed\n"); grid = -1; return; }
        if (hipOccupancyMaxActiveBlocksPerMultiprocessor(&per_cu, (const void*)fwd_kernel, NTHREADS, LDS_BYTES) != hipSuccess || per_cu < 1) { fprintf(stderr, "kernel_launch: occupancy query says %d blocks/CU\n", per_cu); per_cu = 1; }
        (void)hipGetLastError();
        grid = cus * per_cu; if (grid > 256) grid = 256; if (grid % 8) grid -= grid % 8;
    }
    if (grid <= 0) return;
    Params p{};
    p.x = (const float*)d_in[0]; p.c = (const float*)d_in[1]; p.pos = (const int*)d_in[2]; p.w_ada = (const float*)d_in[3]; p.b_ada = (const float*)d_in[4];
    p.norm1_g = (const float*)d_in[5]; p.norm2_g = (const float*)d_in[6]; p.w_in = (const float*)d_in[7]; p.q_norm_g = (const float*)d_in[8]; p.w_uq = (const float*)d_in[9];
    p.kv_norm_g = (const float*)d_in[10]; p.w_ukv = (const float*)d_in[11]; p.w_o_mla = (const float*)d_in[12]; p.w_o_sb = (const float*)d_in[13]; p.w_o_moba = (const float*)d_in[14];
    p.w_out = (const float*)d_in[15]; p.w_ff1 = (const float*)d_in[16]; p.w_ff2 = (const float*)d_in[17]; p.final_g = (const float*)d_in[18];
    p.out = (float*)d_out; p.ws = (unsigned char*)d_ws; p.ph_lo = 0; p.ph_hi = NPHASE;
    (void)hipMemsetAsync((char*)d_ws + WS_BAR, 0, 16384, stream);
    void* args[] = {&p};
    hipError_t e = hipLaunchCooperativeKernel((const void*)fwd_kernel, dim3(grid), dim3(NTHREADS), args, LDS_BYTES, stream);
    if (e != hipSuccess) fprintf(stderr, "kernel_launch: cooperative launch failed: %s (grid %d)\n", hipGetErrorString(e), grid);
}
```

```cpp
#include <hip/hip_runtime.h>
#include <hip/hip_cooperative_groups.h>
#include <cstdio>
#include <cstdint>
namespace cg = cooperative_groups;

#define LAS __attribute__((address_space(3)))
#define DI __device__ __forceinline__
typedef unsigned short bf16_t;
typedef short bf16x8 __attribute__((ext_vector_type(8)));
typedef short s16x4 __attribute__((ext_vector_type(4)));
typedef float f32x4 __attribute__((ext_vector_type(4)));
typedef float f32x2 __attribute__((ext_vector_type(2)));
typedef float f32x16 __attribute__((ext_vector_type(16)));
typedef unsigned u32x4 __attribute__((ext_vector_type(4)));
typedef unsigned u32x2 __attribute__((ext_vector_type(2)));
typedef __bf16 bf16x2_t __attribute__((ext_vector_type(2)));

constexpr int T = 32768, SEQ = 4096, NB = 8, DM = 1024, DFF = 4096, DEPTH = 2;
constexpr float EPS = 1e-6f;
constexpr float LOG2E = 1.4426950408889634f;
constexpr float C_MLA = 0.10206207261596577f * LOG2E;
constexpr float C_MB = 0.125f * LOG2E;
constexpr int NWIN = 7424;

constexpr size_t MiB = 1u << 20;
constexpr size_t WS_CTR = 0;
constexpr size_t WS_MOD = 1 * MiB;
constexpr size_t WS_SSQQ = 2 * MiB;
constexpr size_t WS_SSQKV = 2 * MiB + 256 * 1024;
constexpr size_t WS_SSQX = 2 * MiB + 512 * 1024;
constexpr size_t WS_KMEAN = 3 * MiB;
constexpr size_t WS_ROPEM = 4 * MiB;
constexpr size_t WS_ROPEB = 8 * MiB;
constexpr size_t WS_BIAS1 = 10 * MiB;
constexpr size_t WS_BIAS2 = 11 * MiB;
constexpr size_t WS_W = 16 * MiB;
constexpr size_t W_IN = WS_W, W_UQ = WS_W + 15 * MiB, W_UKV = WS_W + 16 * MiB + 512 * 1024, W_O = WS_W + 17 * MiB, W_OUT = WS_W + 20 * MiB, W_FF1 = WS_W + 22 * MiB, W_FF2 = WS_W + 30 * MiB;
constexpr size_t WS_HDN = 56 * MiB;
constexpr size_t WS_QLAT = 120 * MiB;
constexpr size_t WS_CKV = 168 * MiB;
constexpr size_t WS_OMLA = 120 * MiB;
constexpr size_t WS_KPE = 184 * MiB;
constexpr size_t WS_SB = 186 * MiB;
constexpr size_t WS_MB = 282 * MiB;
constexpr size_t WS_QMLA = 378 * MiB;
constexpr size_t WS_STASH = 378 * MiB;
constexpr size_t WS_KVMLA = 426 * MiB;
constexpr size_t WS_MERGED = 426 * MiB;
constexpr size_t WS_H = 186 * MiB;
constexpr size_t WS_SSQXP = 490 * MiB;
constexpr size_t WS_SSQQP = 498 * MiB;
constexpr size_t WS_SSQKVP = 500 * MiB;
constexpr size_t WS_END = 502 * MiB;

constexpr int LDS_BYTES = 147456;
constexpr int NTHREADS = 512;

DI int tid_opaque() { int t = threadIdx.x; asm volatile("" : "+v"(t)); return t; }
DI unsigned pk2(float lo, float hi) { f32x2 v = {lo, hi}; bf16x2_t b = __builtin_convertvector(v, bf16x2_t); return __builtin_bit_cast(unsigned, b); }
DI float bf_lo(unsigned u) { return __uint_as_float(u << 16); }
DI float bf_hi(unsigned u) { return __uint_as_float(u & 0xffff0000u); }
DI u32x2 pk4(f32x4 v) { u32x2 r; r.x = pk2(v[0], v[1]); r.y = pk2(v[2], v[3]); return r; }
DI float wave_sum(float v) {
#pragma unroll
    for (int o = 32; o >= 1; o >>= 1) v += __shfl_xor(v, o);
    return v;
}
DI float fast_exp2(float x) { return __builtin_amdgcn_exp2f(x); }
DI float fast_exp(float x) { return __builtin_amdgcn_exp2f(x * LOG2E); }
DI float fast_log(float x) { return __builtin_amdgcn_logf(x) * 0.6931471805599453f; }
DI float sigmoidf_(float x) { return __builtin_amdgcn_rcpf(1.f + fast_exp(-x)); }

DI float sum16(const float* p) { const f32x4 a = *(const f32x4*)p, b = *(const f32x4*)(p + 4), c = *(const f32x4*)(p + 8), d = *(const f32x4*)(p + 12); return (((a[0] + a[1]) + (a[2] + a[3])) + ((b[0] + b[1]) + (b[2] + b[3]))) + (((c[0] + c[1]) + (c[2] + c[3])) + ((d[0] + d[1]) + (d[2] + d[3]))); }
DI float sum12(const float* p) { const f32x4 a = *(const f32x4*)p, b = *(const f32x4*)(p + 4), c = *(const f32x4*)(p + 8); return (((a[0] + a[1]) + (a[2] + a[3])) + ((b[0] + b[1]) + (b[2] + b[3]))) + ((c[0] + c[1]) + (c[2] + c[3])); }
DI float sum4(const float* p) { const f32x4 a = *(const f32x4*)p; return (a[0] + a[1]) + (a[2] + a[3]); }

struct Params {
    const float* x; const float* c; const int* pos; const float* w_ada; const float* b_ada; const float* norm1_g; const float* norm2_g;
    const float* w_in; const float* q_norm_g; const float* w_uq; const float* kv_norm_g; const float* w_ukv;
    const float* w_o_mla; const float* w_o_sb; const float* w_o_moba; const float* w_out; const float* w_ff1; const float* w_ff2; const float* final_g;
    float* out; unsigned char* ws;
    int ph_lo, ph_hi;
};

typedef const Params __attribute__((address_space(4)))* PP;

namespace pg8 {
constexpr int BM = 256, BK = 64, HALF = 128, HTB = HALF * BK * 2, STAGE_BYTES = 8 * HTB, NXCD = 8, WGM = 8;
DI int lds_byte(int r, int c) { const int st = (r >> 4) * 2 + (c >> 5), rr = r & 15, cc = c & 31, ob = rr * 64 + cc * 2; return st * 1024 + (ob ^ (((ob >> 9) & 1) << 5)); }
DI int perm32(int rho) { const int n = rho >> 4, i = rho & 15; return 8 * (i >> 2) + 4 * n + (i & 3); }
DI void stage_rc(int b, int& R, int& C) { const int st = b / 1024, sb = b % 1024, swz = sb ^ (((sb >> 9) & 1) << 5); R = (st >> 1) * 16 + swz / 64; C = (st & 1) * 32 + (swz % 64) / 2; }

enum { K_QLAT = 0, K_CKV, K_KPE, K_SB, K_MB, K_UQ, K_UKV, K_GATE, K_BR0, K_BR1, K_BR2, K_OUT, K_FF1, K_FF2 };
enum { M_PROJ = 0, M_UP, M_MERGE, M_OUT, M_FF1, M_FF2 };

struct Unit { const char* A; const char* B; int lda, ldb; int nt, kind; int pm, pn; };

DI void tile_map(int L, int nM, int nN, int& pm, int& pn) {
    const int nwg = nM * nN; int wgid = L;
    { const int q = nwg / NXCD, r = nwg % NXCD, xcd = wgid % NXCD, off = wgid / NXCD; wgid = (xcd < r ? xcd * (q + 1) : r * (q + 1) + (xcd - r) * q) + off; }
    const int nig = WGM * nN, gid = wgid / nig, fm = gid * WGM, gsz = (nM - fm) < WGM ? (nM - fm) : WGM;
    pm = __builtin_amdgcn_readfirstlane(fm + ((wgid % nig) % gsz)); pn = __builtin_amdgcn_readfirstlane((wgid % nig) / gsz);
}

struct Sched {
    int mode, G, c; const char* ws;
    DI bool next(int i, Unit& u) const {
        const int nM = T / BM;
        if (mode == M_PROJ) {
            const long L = (long)i * G + c; if (L >= nM * 17) return false;
            tile_map((int)L, nM, 17, u.pm, u.pn);
            u.lda = 2048; u.ldb = 2048; u.nt = 16;
            u.A = ws + WS_HDN + (size_t)u.pm * BM * 2048; u.B = ws + W_IN + (size_t)u.pn * BM * 2048;
            u.kind = u.pn < 3 ? K_QLAT : (u.pn == 3 ? K_CKV : (u.pn == 4 ? K_KPE : (u.pn < 11 ? K_SB : K_MB)));
            return true;
        } else if (mode == M_UP) {
            const long L = (long)i * G + c; if (L >= nM * 7) return false;
            if (L < nM * 3) { tile_map((int)L, nM, 3, u.pm, u.pn); u.lda = 1536; u.ldb = 1536; u.nt = 12; u.kind = K_UQ;
                u.A = ws + WS_QLAT + (size_t)u.pm * BM * 1536; u.B = ws + W_UQ + (size_t)u.pn * BM * 1536; }
            else { tile_map((int)L - nM * 3, nM, 4, u.pm, u.pn); u.lda = 512; u.ldb = 512; u.nt = 4; u.kind = K_UKV;
                u.A = ws + WS_CKV + (size_t)u.pm * BM * 512; u.B = ws + W_UKV + (size_t)u.pn * BM * 512; }
            return true;
        } else if (mode == M_MERGE) {
            const int tl = i / 6, sub = i - tl * 6, br = sub >> 1;
            const long L = (long)tl * G + c; if (L >= nM * 4) return false;
            tile_map((int)L, nM, 4, u.pm, u.pn);
            if ((sub & 1) == 0) { u.lda = 2048; u.ldb = 2048; u.nt = 16; u.kind = K_GATE;
                u.A = ws + WS_HDN + (size_t)u.pm * BM * 2048; u.B = ws + W_IN + (size_t)(4352 + br * 1024 + u.pn * BM) * 2048; }
            else { u.ldb = 1024; u.nt = 8; u.kind = K_BR0 + br;
                u.lda = br == 0 ? 1024 : 3072;
                u.A = ws + (br == 0 ? WS_OMLA : (br == 1 ? WS_SB : WS_MB)) + (size_t)u.pm * BM * u.lda;
                u.B = ws + W_O + (size_t)(br * 1024 + u.pn * BM) * 1024; }
            return true;
        } else if (mode == M_OUT) {
            const long L = (long)i * G + c; if (L >= nM * 4) return false;
            tile_map((int)L, nM, 4, u.pm, u.pn); u.lda = 2048; u.ldb = 2048; u.nt = 16; u.kind = K_OUT;
            u.A = ws + WS_MERGED + (size_t)u.pm * BM * 2048; u.B = ws + W_OUT + (size_t)u.pn * BM * 2048; return true;
        } else if (mode == M_FF1) {
            const long L = (long)i * G + c; if (L >= nM * 16) return false;
            tile_map((int)L, nM, 16, u.pm, u.pn); u.lda = 2048; u.ldb = 2048; u.nt = 16; u.kind = K_FF1;
            u.A = ws + WS_HDN + (size_t)u.pm * BM * 2048; u.B = ws + W_FF1 + (size_t)u.pn * BM * 2048; return true;
        } else {
            const long L = (long)i * G + c; if (L >= nM * 4) return false;
            tile_map((int)L, nM, 4, u.pm, u.pn); u.lda = 8192; u.ldb = 8192; u.nt = 64; u.kind = K_FF2;
            u.A = ws + WS_H + (size_t)u.pm * BM * 8192; u.B = ws + W_FF2 + (size_t)u.pn * BM * 8192; return true;
        }
    }
};

struct Epi {
    PP pp; int l;
    template <int NS> DI void rowstat(float (&rs)[2][4], const float* parts, float inv_n, float mul, int rowbase_wave, LAS float* buf, int lane, int fr) const {
#pragma unroll
        for (int h = 0; h < 2; ++h) { const float* pp = parts + (size_t)(rowbase_wave + h * 128 + lane) * (NS == 4 ? 4 : 16);
            const float sm = NS == 16 ? sum16(pp) : (NS == 12 ? sum12(pp) : sum4(pp)); buf[h * 64 + lane] = __builtin_amdgcn_rsqf(sm * inv_n + EPS) * mul; }
#pragma unroll
        for (int ai = 0; ai < 2; ++ai)
#pragma unroll
            for (int m = 0; m < 4; ++m) rs[ai][m] = buf[ai * 64 + m * 16 + fr];
    }
    DI void operator()(const f32x4 (&acc)[2][2][4][2], const Unit& u, int wr, int wc, int fr, int fq, int tid, LAS unsigned char* lds) const {
        asm volatile("" : "+v"(fr), "+v"(fq), "+v"(tid));
        PP q = pp; asm volatile("" : "+s"(q));
        unsigned char* ws = q->ws; float* out = q->out; const float* xin = l == 0 ? q->x : q->out;
        const float* mod = (const float*)(ws + WS_MOD) + (size_t)l * 8 * 6144;
        float* ssqx = (float*)(ws + WS_SSQXP);
        const float* ssq1 = ssqx + (size_t)l * T * 16; float* ssq2 = ssqx + (size_t)3 * T * 16; float* ssqn = ssqx + (size_t)(l + 1) * T * 16;
        const float* bias1 = (const float*)(ws + WS_BIAS1) + (size_t)l * 8 * NWIN; const float* bias2 = (const float*)(ws + WS_BIAS2) + (size_t)l * 8 * 4096;
        const float* g2 = q->norm2_g + l * 1024; const float* g1n = q->norm1_g + ((l + 1) % DEPTH) * 1024; const float* modn = (const float*)(ws + WS_MOD) + (size_t)((l + 1) % DEPTH) * 8 * 6144;
        const int rbw = u.pm * BM + wr * 64, bidx = (u.pm * BM) >> 12;
#define EPI_CASE_BEGIN asm volatile("" : "+v"(fr), "+v"(fq), "+v"(tid)); const int row0 = u.pm * BM + wr * 64 + fr, lc0 = wc * 32 + fq * 8, lane = tid & 63; LAS float* rsbuf = (LAS float*)(lds + 131072) + (tid >> 6) * 128; float rs[2][4]; (void)row0; (void)lc0; (void)lane; (void)rsbuf; (void)rs;
#define PK8(v0, v1) ((u32x4){pk2((v0)[0], (v0)[1]), pk2((v0)[2], (v0)[3]), pk2((v1)[0], (v1)[1]), pk2((v1)[2], (v1)[3])})
        switch (u.kind) {
        case K_QLAT: case K_CKV: { EPI_CASE_BEGIN
            const bool isq = u.kind == K_QLAT;
            bf16_t* dst = (bf16_t*)(ws + (isq ? WS_QLAT : WS_CKV)); const int ld = isq ? 768 : 256; const int cb = isq ? u.pn * 256 : 0;
            float* ssq = (float*)(ws + (isq ? WS_SSQQP : WS_SSQKVP));
            rowstat<16>(rs, ssq1, 1.f / 1024.f, 1.f, rbw, rsbuf, lane, fr);
            f32x4 bv[2][2];
#pragma unroll
            for (int bj = 0; bj < 2; ++bj)
#pragma unroll
                for (int n = 0; n < 2; ++n) bv[bj][n] = *(const f32x4*)(bias1 + bidx * NWIN + u.pn * 256 + lc0 + bj * 128 + n * 4);
#pragma unroll
            for (int ai = 0; ai < 2; ++ai)
#pragma unroll
                for (int m = 0; m < 4; ++m) { const int row = row0 + ai * 128 + m * 16; float s = 0.f;
#pragma unroll
                    for (int bj = 0; bj < 2; ++bj) { const f32x4 v0 = acc[ai][bj][m][0] * rs[ai][m] + bv[bj][0], v1 = acc[ai][bj][m][1] * rs[ai][m] + bv[bj][1];
                        s += ((v0[0] * v0[0] + v0[1] * v0[1]) + (v0[2] * v0[2] + v0[3] * v0[3])) + ((v1[0] * v1[0] + v1[1] * v1[1]) + (v1[2] * v1[2] + v1[3] * v1[3]));
                        *(u32x4*)(dst + (size_t)row * ld + cb + lc0 + bj * 128) = PK8(v0, v1); }
                    s += __shfl_xor(s, 16); s += __shfl_xor(s, 32);
                    if (fq == 0) { if (isq) ssq[(size_t)row * 16 + u.pn * 4 + wc] = s; else ssq[(size_t)row * 4 + wc] = s; } }
        } break;
        case K_KPE: { EPI_CASE_BEGIN
            if (wc == 0) {
                bf16_t* dst = (bf16_t*)(ws + WS_KPE); const float* rt = (const float*)(ws + WS_ROPEM);
                rowstat<16>(rs, ssq1, 1.f / 1024.f, 1.f, rbw, rsbuf, lane, fr);
                const f32x4 b0 = *(const f32x4*)(bias1 + bidx * NWIN + 1024 + fq * 8), b1 = *(const f32x4*)(bias1 + bidx * NWIN + 1024 + fq * 8 + 4);
#pragma unroll
                for (int ai = 0; ai < 2; ++ai)
#pragma unroll
                    for (int m = 0; m < 4; ++m) { const int row = row0 + ai * 128 + m * 16;
                        const float* rr = rt + (size_t)row * 32 + (fq & 1) * 8;
                        const f32x4 cs0 = *(const f32x4*)rr, cs1 = *(const f32x4*)(rr + 4), sn0 = *(const f32x4*)(rr + 16), sn1 = *(const f32x4*)(rr + 20);
                        const f32x4 v0 = acc[ai][0][m][0] * rs[ai][m] + b0, v1 = acc[ai][0][m][1] * rs[ai][m] + b1; f32x4 p0, p1;
#pragma unroll
                        for (int e = 0; e < 4; ++e) { p0[e] = __shfl_xor(v0[e], 32); p1[e] = __shfl_xor(v1[e], 32); }
                        const f32x4 o0 = fq < 2 ? (v0 * cs0 - p0 * sn0) : (p0 * sn0 + v0 * cs0), o1 = fq < 2 ? (v1 * cs1 - p1 * sn1) : (p1 * sn1 + v1 * cs1);
                        *(u32x4*)(dst + (size_t)row * 32 + fq * 8) = PK8(o0, o1); }
            }
        } break;
        case K_SB: case K_MB: { EPI_CASE_BEGIN
            const bool ismb = u.kind == K_MB;
            const int t = u.pn - (ismb ? 11 : 5); bf16_t* dst = (bf16_t*)(ws + (ismb ? WS_MB : WS_SB)); const float sc = t < 2 ? C_MB : 1.f;   const float* rt = (const float*)(ws + WS_ROPEB);
            const bool rope = ismb && (t < 4) && ((wc & 1) == 0);
            rowstat<16>(rs, ssq1, 1.f / 1024.f, 1.f, rbw, rsbuf, lane, fr);
            f32x4 bv[2][2];
#pragma unroll
            for (int bj = 0; bj < 2; ++bj)
#pragma unroll
                for (int n = 0; n < 2; ++n) bv[bj][n] = *(const f32x4*)(bias1 + bidx * NWIN + u.pn * 256 + lc0 + bj * 128 + n * 4);
#pragma unroll
            for (int ai = 0; ai < 2; ++ai)
#pragma unroll
                for (int m = 0; m < 4; ++m) { const int row = row0 + ai * 128 + m * 16;
                    f32x4 cs0 = {1.f, 1.f, 1.f, 1.f}, cs1 = cs0, sn0 = {0.f, 0.f, 0.f, 0.f}, sn1 = sn0;
                    if (rope) { const float* rr = rt + (size_t)row * 16; cs0 = *(const f32x4*)rr; cs1 = *(const f32x4*)(rr + 4); sn0 = *(const f32x4*)(rr + 8); sn1 = *(const f32x4*)(rr + 12); }
#pragma unroll
                    for (int bj = 0; bj < 2; ++bj) { f32x4 v0 = acc[ai][bj][m][0] * rs[ai][m] + bv[bj][0], v1 = acc[ai][bj][m][1] * rs[ai][m] + bv[bj][1];
                        if (rope) { f32x4 p0, p1;
#pragma unroll
                            for (int e = 0; e < 4; ++e) { p0[e] = __shfl_xor(v0[e], 16); p1[e] = __shfl_xor(v1[e], 16); }
                            if (fq == 0) { v0 = v0 * cs0 - p0 * sn0; v1 = v1 * cs1 - p1 * sn1; } else if (fq == 1) { v0 = p0 * sn0 + v0 * cs0; v1 = p1 * sn1 + v1 * cs1; } }
                        v0 = v0 * sc; v1 = v1 * sc;
                        *(u32x4*)(dst + (size_t)row * 1536 + t * 256 + lc0 + bj * 128) = PK8(v0, v1); } }
        } break;
        case K_UQ: { EPI_CASE_BEGIN
            bf16_t* dst = (bf16_t*)(ws + WS_QMLA); const float* rt = (const float*)(ws + WS_ROPEM);
            rowstat<12>(rs, (const float*)(ws + WS_SSQQP), 1.f / 768.f, C_MLA, rbw, rsbuf, lane, fr);
#pragma unroll
            for (int ai = 0; ai < 2; ++ai)
#pragma unroll
                for (int m = 0; m < 4; ++m) { const int row = row0 + ai * 128 + m * 16;
                    const float* rr = rt + (size_t)row * 32 + (fq & 1) * 8;
                    const f32x4 cs0 = *(const f32x4*)rr, cs1 = *(const f32x4*)(rr + 4), sn0 = *(const f32x4*)(rr + 16), sn1 = *(const f32x4*)(rr + 20);
#pragma unroll
                    for (int bj = 0; bj < 2; ++bj) { const int gc = u.pn * 256 + bj * 128 + wc * 32; const bool pe = ((gc >> 5) % 3) == 2;
                        f32x4 v0 = acc[ai][bj][m][0] * rs[ai][m], v1 = acc[ai][bj][m][1] * rs[ai][m];
                        if (pe) { f32x4 p0, p1;
#pragma unroll
                            for (int e = 0; e < 4; ++e) { p0[e] = __shfl_xor(v0[e], 32); p1[e] = __shfl_xor(v1[e], 32); }
                            if (fq < 2) { v0 = v0 * cs0 - p0 * sn0; v1 = v1 * cs1 - p1 * sn1; } else { v0 = p0 * sn0 + v0 * cs0; v1 = p1 * sn1 + v1 * cs1; } }
                        *(u32x4*)(dst + (size_t)row * 768 + gc + fq * 8) = PK8(v0, v1); } }
        } break;
        case K_UKV: { EPI_CASE_BEGIN
            bf16_t* dst = (bf16_t*)(ws + WS_KVMLA);
            rowstat<4>(rs, (const float*)(ws + WS_SSQKVP), 1.f / 256.f, 1.f, rbw, rsbuf, lane, fr);
#pragma unroll
            for (int ai = 0; ai < 2; ++ai)
#pragma unroll
                for (int m = 0; m < 4; ++m) { const int row = row0 + ai * 128 + m * 16;
#pragma unroll
                    for (int bj = 0; bj < 2; ++bj) { const f32x4 v0 = acc[ai][bj][m][0] * rs[ai][m], v1 = acc[ai][bj][m][1] * rs[ai][m];
                        *(u32x4*)(dst + (size_t)row * 1024 + u.pn * 256 + lc0 + bj * 128) = PK8(v0, v1); } }
        } break;
        case K_GATE: { EPI_CASE_BEGIN
            u32x4* st = (u32x4*)(ws + WS_STASH + (size_t)blockIdx.x * 131072) + tid;
            const int gcol = (int)((u.B - (const char*)(ws + W_IN)) >> 11) + lc0;
            rowstat<16>(rs, ssq1, 1.f / 1024.f, 1.f, rbw, rsbuf, lane, fr);
            f32x4 bv[2][2];
#pragma unroll
            for (int bj = 0; bj < 2; ++bj)
#pragma unroll
                for (int n = 0; n < 2; ++n) bv[bj][n] = *(const f32x4*)(bias1 + bidx * NWIN + gcol + bj * 128 + n * 4);
#pragma unroll
            for (int ai = 0; ai < 2; ++ai)
#pragma unroll
                for (int m = 0; m < 4; ++m)
#pragma unroll
                    for (int bj = 0; bj < 2; ++bj) { f32x4 g0, g1;
                        const f32x4 a0 = acc[ai][bj][m][0] * rs[ai][m] + bv[bj][0], a1 = acc[ai][bj][m][1] * rs[ai][m] + bv[bj][1];
#pragma unroll
                        for (int e = 0; e < 4; ++e) { g0[e] = sigmoidf_(a0[e]); g1[e] = sigmoidf_(a1[e]); }
                        st[((ai * 4 + m) * 2 + bj) * 512] = PK8(g0, g1); }
        } break;
        case K_BR0: case K_BR1: case K_BR2: { EPI_CASE_BEGIN
            const u32x4* st = (const u32x4*)(ws + WS_STASH + (size_t)blockIdx.x * 131072) + tid; bf16_t* dst = (bf16_t*)(ws + WS_MERGED);
            const bool first = u.kind == K_BR0;
#pragma unroll
            for (int ai = 0; ai < 2; ++ai)
#pragma unroll
                for (int m = 0; m < 4; ++m) { const int row = row0 + ai * 128 + m * 16;
#pragma unroll
                    for (int bj = 0; bj < 2; ++bj) { const u32x4 g = st[((ai * 4 + m) * 2 + bj) * 512];
                        u32x4* d = (u32x4*)(dst + (size_t)row * 1024 + u.pn * 256 + lc0 + bj * 128);
                        const f32x4 a0 = acc[ai][bj][m][0], a1 = acc[ai][bj][m][1];
                        f32x4 r0 = {bf_lo(g.x) * a0[0], bf_hi(g.x) * a0[1], bf_lo(g.y) * a0[2], bf_hi(g.y) * a0[3]}, r1 = {bf_lo(g.z) * a1[0], bf_hi(g.z) * a1[1], bf_lo(g.w) * a1[2], bf_hi(g.w) * a1[3]};
                        if (!first) { const u32x4 o = *d; r0[0] += bf_lo(o.x); r0[1] += bf_hi(o.x); r0[2] += bf_lo(o.y); r0[3] += bf_hi(o.y); r1[0] += bf_lo(o.z); r1[1] += bf_hi(o.z); r1[2] += bf_lo(o.w); r1[3] += bf_hi(o.w); }
                        *d = PK8(r0, r1); } }
        } break;
        case K_OUT: case K_FF2: { EPI_CASE_BEGIN
            const bool isout = u.kind == K_OUT;
            const int goff = isout ? 2048 : 5120; const float* src = isout ? xin : out;
            const float* gn = isout ? g2 : g1n; const float* mn = isout ? mod + 4096 : modn + 1024;
            float* ssqo = isout ? ssq2 : ssqn; bf16_t* hd = (bf16_t*)(ws + WS_HDN);
            const bool lastff2 = !isout && (l + 1 == DEPTH);
            f32x4 gv[2][2], fac[2][2];
#pragma unroll
            for (int bj = 0; bj < 2; ++bj)
#pragma unroll
                for (int n = 0; n < 2; ++n) { const int col = u.pn * 256 + lc0 + bj * 128 + n * 4;
                    gv[bj][n] = *(const f32x4*)(mod + bidx * 6144 + goff + col);
                    fac[bj][n] = lastff2 ? (f32x4){1.f, 1.f, 1.f, 1.f} : *(const f32x4*)(gn + col) * (*(const f32x4*)(mn + bidx * 6144 + col) + 1.f); }
            bf16_t* xb = (bf16_t*)out;
            const bool f32res = isout && l == 0;
#pragma unroll
            for (int ai = 0; ai < 2; ++ai)
#pragma unroll
                for (int m = 0; m < 4; ++m) { __builtin_amdgcn_sched_barrier(0);
                    const size_t ro = (size_t)(row0 + ai * 128 + m * 16) * 1024 + u.pn * 256 + lc0; float sv = 0.f;
#pragma unroll
                    for (int bj = 0; bj < 2; ++bj) { const int co = bj * 128;
                        f32x4 r0, r1;
                        if (f32res) { r0 = *(const f32x4*)(src + ro + co); r1 = *(const f32x4*)(src + ro + co + 4); }
                        else { const u32x4 rb = *(const u32x4*)(xb + ro + co); r0 = (f32x4){bf_lo(rb.x), bf_hi(rb.x), bf_lo(rb.y), bf_hi(rb.y)}; r1 = (f32x4){bf_lo(rb.z), bf_hi(rb.z), bf_lo(rb.w), bf_hi(rb.w)}; }
                        const f32x4 x0 = r0 + gv[bj][0] * acc[ai][bj][m][0], x1 = r1 + gv[bj][1] * acc[ai][bj][m][1];
                        if (!lastff2) *(u32x4*)(xb + ro + co) = PK8(x0, x1);
                        sv += ((x0[0] * x0[0] + x0[1] * x0[1]) + (x0[2] * x0[2] + x0[3] * x0[3])) + ((x1[0] * x1[0] + x1[1] * x1[1]) + (x1[2] * x1[2] + x1[3] * x1[3]));
                        const f32x4 h0 = x0 * fac[bj][0], h1 = x1 * fac[bj][1];
                        *(u32x4*)(hd + ro + co) = PK8(h0, h1); }
                    sv += __shfl_xor(sv, 16); sv += __shfl_xor(sv, 32);
                    if (fq == 0) ssqo[(size_t)(row0 + ai * 128 + m * 16) * 16 + u.pn * 4 + wc] = sv; }
        } break;
        case K_FF1: { EPI_CASE_BEGIN
            bf16_t* dst = (bf16_t*)(ws + WS_H);
            rowstat<16>(rs, ssq2, 1.f / 1024.f, 1.f, rbw, rsbuf, lane, fr);
            f32x4 bv[2][2];
#pragma unroll
            for (int bj = 0; bj < 2; ++bj)
#pragma unroll
                for (int n = 0; n < 2; ++n) bv[bj][n] = *(const f32x4*)(bias2 + bidx * 4096 + u.pn * 256 + lc0 + bj * 128 + n * 4);
#pragma unroll
            for (int ai = 0; ai < 2; ++ai)
#pragma unroll
                for (int m = 0; m < 4; ++m) { const int row = row0 + ai * 128 + m * 16;
#pragma unroll
                    for (int bj = 0; bj < 2; ++bj) { f32x4 v0 = acc[ai][bj][m][0] * rs[ai][m] + bv[bj][0], v1 = acc[ai][bj][m][1] * rs[ai][m] + bv[bj][1];
#pragma unroll
                        for (int e = 0; e < 4; ++e) { const float t0 = fmaxf(v0[e], 0.f), t1 = fmaxf(v1[e], 0.f); v0[e] = t0 * t0; v1[e] = t1 * t1; }
                        *(u32x4*)(dst + (size_t)row * 4096 + u.pn * 256 + lc0 + bj * 128) = PK8(v0, v1); } }
        } break;
        }
    }
};

DI void gemm_phase(LAS unsigned char* lds, const Sched& S_, const Epi& E) {
    Sched S = S_; asm volatile("" : "+s"(S.c));
    const int tid = tid_opaque(), wid = __builtin_amdgcn_readfirstlane(tid >> 6), lane = tid & 63, wr = wid >> 2, wc = wid & 3, fr = lane & 15, fq = lane >> 4;
    int sR[2], sRb[2], sC[2];
#pragma unroll
    for (int i = 0; i < 2; ++i) { int R, C; stage_rc(tid * 16 + i * 8192, R, C); sR[i] = R; sRb[i] = (R & ~31) + perm32(R & 31); sC[i] = C * 2; }
    const size_t kstep = (size_t)(BK * 2);
    const unsigned ldsw = (unsigned)wid * 1024u;
    const int aoff = lds_byte(wr * 64 + fr, fq * 8), boff = lds_byte(wc * 32 + fr, fq * 8);
#define PG8_SA(b, h) (((b) * 2 + (h)) * HTB)
#define PG8_SB(b, h) ((4 + (b) * 2 + (h)) * HTB)
#define PG8_STAGE_(RR, bufoff, gbase, ld) do { _Pragma("unroll") for (int _i = 0; _i < 2; ++_i) \
        __builtin_amdgcn_global_load_lds((const unsigned*)((const char*)(gbase) + (unsigned)(RR[_i] * (ld) + sC[_i])), (LAS unsigned*)(lds + (bufoff) + ldsw + _i * 8192), 16, 0, 0); } while (0)
#define PG8_STAGE(bufoff, gbase, ld) do { if ((bufoff) >= 4 * HTB) PG8_STAGE_(sRb, bufoff, gbase, ld); else PG8_STAGE_(sR, bufoff, gbase, ld); } while (0)
#define PG8_LDA(dst, b, h) do { _Pragma("unroll") for (int m = 0; m < 4; ++m) _Pragma("unroll") for (int k = 0; k < 2; ++k) dst[m][k] = *(const LAS bf16x8*)(lds + PG8_SA(b, h) + aoff + m * 2048 + k * 1024); } while (0)
#define PG8_LDB(dst, b, h) do { _Pragma("unroll") for (int n = 0; n < 2; ++n) _Pragma("unroll") for (int k = 0; k < 2; ++k) dst[n][k] = *(const LAS bf16x8*)(lds + PG8_SB(b, h) + boff + n * 2048 + k * 1024); } while (0)
#define PG8_MMA(ai, bj, At, Bt) do { __builtin_amdgcn_s_setprio(1); _Pragma("unroll") for (int m = 0; m < 4; ++m) _Pragma("unroll") for (int n = 0; n < 2; ++n) _Pragma("unroll") for (int k = 0; k < 2; ++k) \
        acc[ai][bj][m][n] = __builtin_amdgcn_mfma_f32_16x16x32_bf16(Bt[n][k], At[m][k], acc[ai][bj][m][n], 0, 0, 0); __builtin_amdgcn_s_setprio(0); } while (0)
#define PG8_WAIT_V(n) asm volatile("s_waitcnt vmcnt(" #n ")" ::: "memory")
#define PG8_WAIT_L(n) asm volatile("s_waitcnt lgkmcnt(" #n ")" ::: "memory")
#define PG8_BAR __builtin_amdgcn_s_barrier()
#define PG8_SCHED __builtin_amdgcn_sched_barrier(0)
    Unit cur, nxt; int ui = 0;
    if (!S.next(0, cur)) return;
    f32x4 acc[2][2][4][2];
#pragma unroll
    for (int a = 0; a < 2; ++a)
#pragma unroll
        for (int b = 0; b < 2; ++b)
#pragma unroll
            for (int m = 0; m < 4; ++m)
#pragma unroll
                for (int n = 0; n < 2; ++n) acc[a][b][m][n] = (f32x4){0.f, 0.f, 0.f, 0.f};
    bf16x8 At[4][2], B0[2][2], B1[2][2];
    const char* cA = cur.A; const char* cB = cur.B; int clda = cur.lda, cldb = cur.ldb;
    {
        const size_t hA = (size_t)HALF * clda, hB = (size_t)HALF * cldb;
        PG8_STAGE(PG8_SB(0, 0), cB, cldb); PG8_STAGE(PG8_SB(0, 1), cB + hB, cldb); PG8_STAGE(PG8_SA(0, 0), cA, clda); PG8_STAGE(PG8_SA(0, 1), cA + hA, clda);
        if (wr == 1) PG8_BAR;
        PG8_WAIT_V(2); PG8_BAR;
        PG8_STAGE(PG8_SB(1, 0), cB + kstep, cldb); PG8_STAGE(PG8_SA(1, 0), cA + kstep, clda); PG8_STAGE(PG8_SB(1, 1), cB + hB + kstep, cldb);
        PG8_WAIT_V(6); PG8_BAR;
    }
    for (;;) {
        const bool has_next = S.next(ui + 1, nxt);
        const char* nA = has_next ? nxt.A : cA; const char* nB = has_next ? nxt.B : cB;
        const int nlda = has_next ? nxt.lda : clda, nldb = has_next ? nxt.ldb : cldb;
        const int nt = cur.nt;
        const size_t hA = (size_t)HALF * clda, hB = (size_t)HALF * cldb, nhA = (size_t)HALF * nlda, nhB = (size_t)HALF * nldb;
        for (int t = 0; t < nt; t += 2) {
            const bool last = (t == nt - 2);
            const char* a1 = cA + (size_t)(t + 1) * kstep;
            const char* a2 = last ? nA : cA + (size_t)(t + 2) * kstep; const char* b2 = last ? nB : cB + (size_t)(t + 2) * kstep;
            const char* a3 = a2 + kstep; const char* b3 = b2 + kstep;
            const int l2a = last ? nlda : clda, l2b = last ? nldb : cldb; const size_t h2a = last ? nhA : hA, h2b = last ? nhB : hB;
            PG8_LDB(B0, 0, 0); PG8_LDB(B1, 0, 1); PG8_SCHED; PG8_LDA(At, 0, 0); PG8_STAGE(PG8_SA(1, 1), a1 + hA, clda);
            PG8_WAIT_V(8); PG8_WAIT_L(0); PG8_BAR; PG8_MMA(0, 0, At, B0); PG8_MMA(0, 1, At, B1); PG8_BAR; PG8_SCHED;
            PG8_LDA(At, 0, 1); PG8_STAGE(PG8_SB(0, 0), b2, l2b); PG8_STAGE(PG8_SB(0, 1), b2 + h2b, l2b); PG8_STAGE(PG8_SA(0, 0), a2, l2a);
            PG8_WAIT_V(8); PG8_WAIT_L(0); PG8_BAR; PG8_MMA(1, 0, At, B0); PG8_MMA(1, 1, At, B1); PG8_BAR; PG8_SCHED;
            PG8_LDB(B0, 1, 0); PG8_LDB(B1, 1, 1); PG8_SCHED; PG8_LDA(At, 1, 0); PG8_STAGE(PG8_SA(0, 1), a2 + h2a, l2a);
            PG8_WAIT_V(8); PG8_WAIT_L(0); PG8_BAR; PG8_MMA(0, 0, At, B0); PG8_MMA(0, 1, At, B1); PG8_BAR; PG8_SCHED;
            PG8_LDA(At, 1, 1); PG8_STAGE(PG8_SB(1, 0), b3, l2b); PG8_STAGE(PG8_SB(1, 1), b3 + h2b, l2b); PG8_STAGE(PG8_SA(1, 0), a3, l2a);
            PG8_WAIT_V(8); PG8_WAIT_L(0); PG8_BAR; PG8_MMA(1, 0, At, B0); PG8_MMA(1, 1, At, B1); PG8_BAR; PG8_SCHED;
        }
        if (wr == 0) PG8_BAR;
        E(acc, cur, wr, wc, fr, fq, tid, lds);
        if (!has_next) break;
#pragma unroll
        for (int a = 0; a < 2; ++a)
#pragma unroll
            for (int b = 0; b < 2; ++b)
#pragma unroll
                for (int m = 0; m < 4; ++m)
#pragma unroll
                    for (int n = 0; n < 2; ++n) acc[a][b][m][n] = (f32x4){0.f, 0.f, 0.f, 0.f};
        cur = nxt; cA = nA; cB = nB; clda = nlda; cldb = nldb; ++ui;
        if (wr == 1) PG8_BAR;
    }
    PG8_WAIT_V(0);
    PG8_BAR;
#undef PG8_SA
#undef PG8_SB
#undef PG8_STAGE
#undef PG8_STAGE_
#undef PG8_LDA
#undef PG8_LDB
#undef PG8_MMA
#undef PG8_WAIT_V
#undef PG8_WAIT_L
#undef PG8_BAR
#undef PG8_SCHED
}
}

#define MFMA32(a, b, c) __builtin_amdgcn_mfma_f32_32x32x16_bf16((a), (b), (c), 0, 0, 0)
DI int crow(int i, int h) { return (i & 3) + 8 * (i >> 2) + 4 * h; }
typedef short v4i16_t __attribute__((ext_vector_type(4)));
DI s16x4 tr_read(const LAS unsigned char* p) { return __builtin_bit_cast(s16x4, __builtin_amdgcn_ds_read_tr16_b64_v4i16((LAS v4i16_t*)p)); }
DI float swap_max(float m) { auto rr = __builtin_amdgcn_permlane32_swap(__float_as_uint(m), __float_as_uint(m), false, false); return fmaxf(__uint_as_float(rr[0]), __uint_as_float(rr[1])); }
DI float swap_sum(float m) { auto rr = __builtin_amdgcn_permlane32_swap(__float_as_uint(m), __float_as_uint(m), false, false); return __uint_as_float(rr[0]) + __uint_as_float(rr[1]); }
DI bf16x8 pack8(const f32x16& x, int s) {
    u32x4 p; p[0] = pk2(x[8 * s], x[8 * s + 1]); p[1] = pk2(x[8 * s + 2], x[8 * s + 3]); p[2] = pk2(x[8 * s + 4], x[8 * s + 5]); p[3] = pk2(x[8 * s + 6], x[8 * s + 7]);
    return __builtin_bit_cast(bf16x8, p);
}

DI float max3f(float a, float b, float c) { float r; asm("v_max3_f32 %0, %1, %2, %3" : "=v"(r) : "v"(a), "v"(b), "v"(c)); return r; }
DI float max2f(float a, float b) { float r; asm("v_max_f32_e32 %0, %1, %2" : "=v"(r) : "v"(a), "v"(b)); return r; }
DI float rowmax32(const f32x16& p0, const f32x16& p1) {
    float a = max3f(p0[0], p0[1], p1[0]), b = max3f(p0[2], p0[3], p1[1]); a = max3f(a, p1[2], p1[3]);
#pragma unroll
    for (int r = 4; r < 16; r += 4) { a = max3f(a, p0[r], p0[r + 1]); b = max3f(b, p0[r + 2], p0[r + 3]); a = max3f(a, p1[r], p1[r + 1]); b = max3f(b, p1[r + 2], p1[r + 3]); }
    const float m = max2f(a, b);
    auto rr = __builtin_amdgcn_permlane32_swap(__float_as_uint(m), __float_as_uint(m), false, false);
    return max2f(__uint_as_float(rr[0]), __uint_as_float(rr[1]));
}
constexpr int AT_K0 = 0, AT_K1 = 16384, AT_V0 = 32768, AT_V1 = 49152, AT_SEL = 65536, AT_MISC = 66560 + 1024, AT_FLAG = 66560 + 2048;
constexpr int VP = 192;

template <int MODE>
DI void attn_unit(unsigned char* ws, int b, int h, int qb, LAS unsigned char* lds, bool do_store = true) {
    constexpr int DQK = MODE == 0 ? 96 : 64, NS = DQK / 16, KP = DQK * 2 + 16;
    constexpr int QPITCH = MODE == 0 ? 768 : 1536, KPITCH = MODE == 0 ? 1024 : 1536, OPITCH = MODE == 0 ? 512 : 1536;
    const bf16_t* Qb = (const bf16_t*)(ws + (MODE == 0 ? WS_QMLA : (MODE == 1 ? WS_SB : WS_MB)));
    const bf16_t* Kb = (const bf16_t*)(ws + (MODE == 0 ? WS_KVMLA : (MODE == 1 ? WS_SB : WS_MB)));
    bf16_t* Ob = (bf16_t*)(ws + (MODE == 0 ? WS_OMLA : (MODE == 1 ? WS_SB : WS_MB)));
    const bf16_t* KPEb = (const bf16_t*)(ws + WS_KPE);
    const int qcol = MODE == 0 ? h * 96 : h * 64, kcol = MODE == 0 ? h * 128 : 512 + h * 64, vcol = MODE == 0 ? h * 128 + 64 : 1024 + h * 64, ocol = h * 64;
    const int tid = tid_opaque(), lane = tid & 63, w = __builtin_amdgcn_readfirstlane(tid >> 6), r = lane & 31, hh = lane >> 5;
    const int q0 = qb * 256; const long rowbase = (long)b * SEQ;
    const int qg = q0 + 32 * w + r;
    bf16x8 qf[NS];
    { const bf16_t* qrow = Qb + (size_t)(rowbase + qg) * QPITCH + qcol + 8 * hh;
#pragma unroll
      for (int s = 0; s < NS; ++s) qf[s] = *(const bf16x8*)(qrow + 16 * s); }
    unsigned mysel = 0;
    if (MODE == 2) {
        if (tid < 256) {
            const bf16_t* qr = Qb + (size_t)(rowbase + q0 + tid) * QPITCH + qcol;
            float qv[64];
#pragma unroll
            for (int c8 = 0; c8 < 8; ++c8) { const u32x4 u = *(const u32x4*)(qr + c8 * 8);
#pragma unroll
                for (int e = 0; e < 4; ++e) { qv[c8 * 8 + 2 * e] = bf_lo(u[e]); qv[c8 * 8 + 2 * e + 1] = bf_hi(u[e]); } }
            const float* km = (const float*)(ws + WS_KMEAN) + (size_t)((b * 8 + h) * 16) * 64;
            float v0 = -INFINITY, v1 = -INFINITY, v2 = -INFINITY; int i0 = -1, i1 = -1, i2 = -1;
            for (int n = 0; n < qb; ++n) { float d = 0.f;
#pragma unroll
                for (int e = 0; e < 64; ++e) d += qv[e] * km[n * 64 + e];
                if (d > v0) { v2 = v1; i2 = i1; v1 = v0; i1 = i0; v0 = d; i0 = n; }
                else if (d > v1) { v2 = v1; i2 = i1; v1 = d; i1 = n; }
                else if (d > v2) { v2 = d; i2 = n; } }
            unsigned mk = 0; if (i0 >= 0) mk |= 1u << i0; if (i1 >= 0) mk |= 1u << i1; if (i2 >= 0) mk |= 1u << i2;
            *(LAS unsigned*)(lds + AT_SEL + tid * 4) = mk;
        }
        __syncthreads();
        mysel = *(LAS unsigned*)(lds + AT_SEL + (32 * w + r) * 4);
    }
    const int kkey = tid >> 3, kch = tid & 7, pkey = (tid & 255) >> 2, pch = tid & 3;
    u32x4 kr[2], vr[2], pr[2];
    pr[0] = (u32x4){0u, 0u, 0u, 0u}; pr[1] = pr[0];
#define AT_LOADG(kt, R) do { const size_t krow_ = (size_t)(rowbase + (kt) * 64 + kkey); \
        kr[R] = *(const u32x4*)(Kb + krow_ * KPITCH + kcol + kch * 8); vr[R] = *(const u32x4*)(Kb + krow_ * KPITCH + vcol + kch * 8); \
        if (MODE == 0 && tid < 256) pr[R] = *(const u32x4*)(KPEb + (size_t)(rowbase + (kt) * 64 + pkey) * 32 + pch * 8); } while (0)
#define AT_STORE(bf, R) do { *(LAS u32x4*)(lds + ((bf) ? AT_K1 : AT_K0) + kkey * KP + kch * 16) = kr[R]; *(LAS u32x4*)(lds + ((bf) ? AT_V1 : AT_V0) + kkey * VP + kch * 16) = vr[R]; \
        if (MODE == 0 && tid < 256) *(LAS u32x4*)(lds + ((bf) ? AT_K1 : AT_K0) + pkey * KP + 128 + pch * 16) = pr[R]; } while (0)
    const int kt_hi = qb * 4 + 3;
    AT_LOADG(kt_hi, 0); AT_LOADG(kt_hi - 1, 1); AT_STORE(0, 0);
    __syncthreads();
    f32x16 o0, o1;
#pragma unroll
    for (int i = 0; i < 16; ++i) { o0[i] = 0.f; o1[i] = 0.f; }
    float carry = (MODE == 1) ? 1.f : 0.f; bool first = true;
    f32x16 lacc;
#pragma unroll
    for (int i = 0; i < 16; ++i) lacc[i] = 0.f;
    float refv = 0.f;
    const short kx0 = (hh == 0) ? (short)0xBF80 : (short)0;
    const bf16x8 kx = {kx0, 0, 0, 0, 0, 0, 0, 0};
    bf16x8 qx = {0, 0, 0, 0, 0, 0, 0, 0};
    const bf16x8 qbig = {(hh == 0) ? (short)0x7149 : (short)0, 0, 0, 0, 0, 0, 0, 0};
    f32x16 zero16;
#pragma unroll
    for (int i = 0; i < 16; ++i) zero16[i] = 0.f;
    const bf16x8 ones = {(short)0x3F80, (short)0x3F80, (short)0x3F80, (short)0x3F80, (short)0x3F80, (short)0x3F80, (short)0x3F80, (short)0x3F80};
    const int i16 = lane & 15, tq = i16 >> 2, tp = i16 & 3, blk = (lane >> 4) & 1;
    const int voff = (4 * hh + tq) * VP + (16 * blk + 4 * tp) * 2;
    const int qmin_w = q0 + 32 * w, qmax_w = qmin_w + 31;
    bool wfin = false, fin = false;
    int kt = kt_hi;
    for (;;) {
#pragma unroll
      for (int half = 0; half < 2; ++half) {
        if (kt >= 2) AT_LOADG(kt - 2, half);
        if (kt * 64 <= qmax_w && !wfin) {
            const LAS unsigned char* kb = lds + (half ? AT_K1 : AT_K0) + r * KP + hh * 16;
            f32x16 p0, p1;
#pragma unroll
            for (int s = 0; s < NS; ++s) {
                const bf16x8 k0 = *(const LAS bf16x8*)(kb + s * 32), k1 = *(const LAS bf16x8*)(kb + 32 * KP + s * 32);
                if (s == 0) { p0 = MFMA32(k0, qf[s], zero16); p1 = MFMA32(k1, qf[s], zero16); }
                else { p0 = MFMA32(k0, qf[s], p0); p1 = MFMA32(k1, qf[s], p1); }
            }
            if (MODE != 1) {
                bf16x8 qe = qx;
                if (MODE == 2) { const int nbk = kt >> 2; const bool dead = (nbk < qb) && !((mysel >> nbk) & 1u); qe = dead ? qbig : qx; }
                p0 = MFMA32(kx, qe, p0); p1 = MFMA32(kx, qe, p1);
            }
            bf16x8 vaf[4][2];
            { const LAS unsigned char* vb = lds + (half ? AT_V1 : AT_V0) + voff;
#pragma unroll
              for (int f = 0; f < 4; ++f) { const LAS unsigned char* vp = vb + (16 * f) * VP;
                  { const s16x4 lo = tr_read(vp), hi = tr_read(vp + 8 * VP); vaf[f][0] = __builtin_shufflevector(lo, hi, 0, 1, 2, 3, 4, 5, 6, 7); }
                  { const s16x4 lo = tr_read(vp + 64), hi = tr_read(vp + 8 * VP + 64); vaf[f][1] = __builtin_shufflevector(lo, hi, 0, 1, 2, 3, 4, 5, 6, 7); } } }
#define AT_PV(f, P, S2) do { const bf16x8 pf_ = pack8(P, S2); o0 = MFMA32(vaf[f][0], pf_, o0); o1 = MFMA32(vaf[f][1], pf_, o1); if (MODE != 1) lacc = MFMA32(ones, pf_, lacc); } while (0)
            const bool needmask = (kt * 64 + 63 >= qmin_w);
            const int kbase = kt * 64;
            if (MODE == 1) {
                f32x16 k0v, k1v;
#pragma unroll
                for (int i = 0; i < 16; ++i) {
                    { const float z = p0[i]; const float e = fast_exp2(-fabsf(z)), rc = __builtin_amdgcn_rcpf(1.f + e), t = e * rc; float bt = z >= 0.f ? rc : t, kp = z >= 0.f ? t : rc;
                      if (needmask && !(kbase + crow(i, hh) < qg)) { bt = 0.f; kp = 1.f; } p0[i] = bt; k0v[i] = kp; }
                    { const float z = p1[i]; const float e = fast_exp2(-fabsf(z)), rc = __builtin_amdgcn_rcpf(1.f + e), t = e * rc; float bt = z >= 0.f ? rc : t, kp = z >= 0.f ? t : rc;
                      if (needmask && !(kbase + 32 + crow(i, hh) < qg)) { bt = 0.f; kp = 1.f; } p1[i] = bt; k1v[i] = kp; }
                }
                float run = carry;
#pragma unroll
                for (int u = 7; u >= 0; --u) {
                    const int g = u & 3;
                    float gs = (u >= 4) ? ((k1v[4 * g] * k1v[4 * g + 1]) * (k1v[4 * g + 2] * k1v[4 * g + 3])) : ((k0v[4 * g] * k0v[4 * g + 1]) * (k0v[4 * g + 2] * k0v[4 * g + 3]));
                    auto rr = __builtin_amdgcn_permlane32_swap(__float_as_uint(gs), __float_as_uint(gs), false, false);
                    const float glo = __uint_as_float(rr[0]), ghi = __uint_as_float(rr[1]);
                    float a = run * (hh == 0 ? ghi : 1.f);
#pragma unroll
                    for (int jj = 3; jj >= 0; --jj) {
                        if (u >= 4) { const float bt = p1[4 * g + jj]; p1[4 * g + jj] = bt * a; a *= k1v[4 * g + jj]; }
                        else { const float bt = p0[4 * g + jj]; p0[4 * g + jj] = bt * a; a *= k0v[4 * g + jj]; }
                    }
                    run *= glo * ghi;
                    if (u == 6) AT_PV(3, p1, 1); else if (u == 4) AT_PV(2, p1, 0); else if (u == 2) AT_PV(1, p0, 1); else if (u == 0) AT_PV(0, p0, 0);
                }
                carry = run;
                wfin = __all(carry < 1.2e-38f);
            } else {
                if (needmask) {
#pragma unroll
                    for (int i = 0; i < 16; ++i) { if (kbase + crow(i, hh) > qg) p0[i] = -INFINITY; if (kbase + 32 + crow(i, hh) > qg) p1[i] = -INFINITY; }
                }
                const float mt = rowmax32(p0, p1);
                if (first || __any(mt > 8.f)) {
                    const float delta = first ? (mt > -1e30f ? mt : 0.f) : (mt > 8.f ? mt : 0.f);
                    const unsigned nb16 = pk2(refv + delta, 0.f) & 0xffffu; const float nref = __uint_as_float(nb16 << 16);
                    const float d2 = nref - refv; const float sc = fast_exp2(-d2);
#pragma unroll
                    for (int i = 0; i < 16; ++i) { p0[i] -= d2; p1[i] -= d2; o0[i] *= sc; o1[i] *= sc; lacc[i] *= sc; }
                    refv = nref; qx[0] = (hh == 0) ? (short)nb16 : (short)0;
                    first = false;
                }
#pragma unroll
                for (int i = 0; i < 8; ++i) p0[i] = fast_exp2(p0[i]);
                AT_PV(0, p0, 0);
#pragma unroll
                for (int i = 8; i < 16; ++i) p0[i] = fast_exp2(p0[i]);
                AT_PV(1, p0, 1);
#pragma unroll
                for (int i = 0; i < 8; ++i) p1[i] = fast_exp2(p1[i]);
                AT_PV(2, p1, 0);
#pragma unroll
                for (int i = 8; i < 16; ++i) p1[i] = fast_exp2(p1[i]);
                AT_PV(3, p1, 1);
            }
#undef AT_PV
        }
        if (kt >= 1) AT_STORE(half ^ 1, half ^ 1);
        if (MODE == 1 && lane == 0) *(LAS unsigned*)(lds + AT_FLAG + half * 32 + w * 4) = wfin ? 1u : 0u;
        asm volatile("s_waitcnt lgkmcnt(0)" ::: "memory"); __builtin_amdgcn_s_barrier(); asm volatile("" ::: "memory");
        if (MODE == 1) { const u32x4 fa = *(const LAS u32x4*)(lds + AT_FLAG + half * 32), fb = *(const LAS u32x4*)(lds + AT_FLAG + half * 32 + 16);
            if ((fa.x & fa.y & fa.z & fa.w & fb.x & fb.y & fb.z & fb.w) != 0u) { fin = true; break; } }
        if (kt == 0) { fin = true; break; }
        --kt;
      }
      if (fin) break;
    }
    if (MODE != 1) { const float inv = 1.f / lacc[0];
#pragma unroll
        for (int i = 0; i < 16; ++i) { o0[i] *= inv; o1[i] *= inv; } }
    bf16_t* orow = Ob + (size_t)(rowbase + qg) * OPITCH + ocol + 4 * hh;
    if (do_store)
#pragma unroll
    for (int g = 0; g < 4; ++g) {
        u32x2 a, c; a.x = pk2(o0[4 * g], o0[4 * g + 1]); a.y = pk2(o0[4 * g + 2], o0[4 * g + 3]); c.x = pk2(o1[4 * g], o1[4 * g + 1]); c.y = pk2(o1[4 * g + 2], o1[4 * g + 3]);
        *(u32x2*)(orow + 8 * g) = a; *(u32x2*)(orow + 32 + 8 * g) = c;
    }
#undef AT_LOADG
#undef AT_STORE
}

DI void attn_phase(unsigned char* ws, LAS unsigned char* lds, unsigned* ctr, bool never) {
    const int tid = tid_opaque();
    for (;;) {
        __syncthreads();
        if (tid == 0) *(LAS int*)(lds + AT_MISC) = (int)atomicAdd(ctr, 1u);
        __syncthreads();
        const int u = *(LAS int*)(lds + AT_MISC);
        if (u >= 3072) break;
        if (u < 2048) { const int qb = 15 - (u >> 7), rem = u & 127, ty = rem >> 6, bh = rem & 63;
#ifdef PROBE_ATT2
            if (ty == 0) { attn_unit<0>(ws, bh >> 3, bh & 7, qb, lds, never); __syncthreads(); } else { attn_unit<2>(ws, bh >> 3, bh & 7, qb, lds, never); __syncthreads(); }
#endif
            if (ty == 0) attn_unit<0>(ws, bh >> 3, bh & 7, qb, lds); else attn_unit<2>(ws, bh >> 3, bh & 7, qb, lds); }
        else { const int v = u - 2048, qb = 15 - (v >> 6), bh = v & 63;
#ifdef PROBE_ATT2
            attn_unit<1>(ws, bh >> 3, bh & 7, qb, lds, never); __syncthreads();
#endif
            attn_unit<1>(ws, bh >> 3, bh & 7, qb, lds); }
    }
}

DI void cvt_T(const float* in, int K, int N, int ldin, bf16_t* out, int ldout, const float* gk, LAS float* tile, int& off) {
    const int tid = tid_opaque(), G = gridDim.x, kts = K / 64, nts = N / 32, ntile = kts * nts;
    for (int t = (int)((blockIdx.x + G - (off % G)) % G); t < ntile; t += G) {
        const int k0 = (t % kts) * 64, n0 = (t / kts) * 32;
#pragma unroll
        for (int i = 0; i < 4; ++i) { const int kl = (tid >> 5) + 16 * i, nl = tid & 31; float v = in[(size_t)(k0 + kl) * ldin + n0 + nl]; if (gk) v *= gk[k0 + kl]; tile[kl * 33 + nl] = v; }
        __syncthreads();
#pragma unroll
        for (int i = 0; i < 2; ++i) { const int nl = (tid >> 5) + 16 * i, kp = tid & 31;
            *(unsigned*)(out + (size_t)(n0 + nl) * ldout + k0 + 2 * kp) = pk2(tile[(2 * kp) * 33 + nl], tile[(2 * kp + 1) * 33 + nl]); }
        __syncthreads();
    }
    off += ntile;
}

DI void phase_bias(const Params& p, int l, LAS unsigned char* lds) {
    const int tid = tid_opaque(), lane = tid & 63, w = tid >> 6; unsigned char* ws = p.ws;
    LAS float* sh = (LAS float*)lds;
    LAS float* red = (LAS float*)(lds + 65536);
    const float* modl = (const float*)(ws + WS_MOD) + (size_t)l * 8 * 6144;
    bool staged = false;
    for (int it = (int)((blockIdx.x + 128) % gridDim.x); it < 177; it += gridDim.x) {
        if (!staged) { for (int i = tid; i < 8192; i += NTHREADS) { sh[i] = modl[(i >> 10) * 6144 + (i & 1023)]; sh[8192 + i] = modl[(i >> 10) * 6144 + 3072 + (i & 1023)]; } staged = true; }
        __syncthreads();
        const bool isin = it < 113; const int n = (isin ? it : it - 113) * 64 + lane; const int ld = isin ? 7200 : 4096; const bool valid = n < ld;
        const float* wa = (isin ? p.w_in + (size_t)l * 1024 * 7200 : p.w_ff1 + (size_t)l * 1024 * 4096) + (valid ? n : 0);
        const LAS float* shp = sh + (isin ? 0 : 8192);
        float a[8];
#pragma unroll
        for (int b = 0; b < 8; ++b) a[b] = 0.f;
#pragma unroll 16
        for (int k = w * 128; k < w * 128 + 128; ++k) { const float wv = wa[(size_t)k * ld];
#pragma unroll
            for (int b = 0; b < 8; ++b) a[b] += shp[b * 1024 + k] * wv; }
#pragma unroll
        for (int b = 0; b < 8; ++b) red[(w * 8 + b) * 64 + lane] = a[b];
        __syncthreads();
        { const int b = w; float sacc = 0.f;
#pragma unroll
          for (int ww = 0; ww < 8; ++ww) sacc += red[(ww * 8 + b) * 64 + lane];
          if (valid) { if (isin) ((float*)(ws + WS_BIAS1))[(size_t)(l * 8 + b) * NWIN + (n < 1056 ? n : n + 224)] = sacc; else ((float*)(ws + WS_BIAS2))[(size_t)(l * 8 + b) * 4096 + n] = sacc; } }
        __syncthreads();
    }
}

DI void phase_convert(const Params& p, int l, LAS unsigned char* lds) {
    LAS float* tile = (LAS float*)lds; unsigned char* ws = p.ws; int off = 0;
    const float* win = p.w_in + (size_t)l * 1024 * 7200;
    cvt_T(win, 1024, 1056, 7200, (bf16_t*)(ws + W_IN), 1024, nullptr, tile, off);
    cvt_T(win + 1056, 1024, 6144, 7200, (bf16_t*)(ws + W_IN) + (size_t)1280 * 1024, 1024, nullptr, tile, off);
    { u32x4* z = (u32x4*)((bf16_t*)(ws + W_IN) + (size_t)1056 * 1024); const int n = 224 * 1024 * 2 / 16;
      for (int i = blockIdx.x * NTHREADS + tid_opaque(); i < n; i += gridDim.x * NTHREADS) z[i] = (u32x4){0u, 0u, 0u, 0u}; }
    cvt_T(p.w_uq + (size_t)l * 768 * 768, 768, 768, 768, (bf16_t*)(ws + W_UQ), 768, p.q_norm_g + l * 768, tile, off);
    cvt_T(p.w_ukv + (size_t)l * 256 * 1024, 256, 1024, 1024, (bf16_t*)(ws + W_UKV), 256, p.kv_norm_g + l * 256, tile, off);
    cvt_T(p.w_o_mla + (size_t)l * 512 * 1024, 512, 1024, 1024, (bf16_t*)(ws + W_O), 512, nullptr, tile, off);
    cvt_T(p.w_o_sb + (size_t)l * 512 * 1024, 512, 1024, 1024, (bf16_t*)(ws + W_O) + (size_t)1024 * 512, 512, nullptr, tile, off);
    cvt_T(p.w_o_moba + (size_t)l * 512 * 1024, 512, 1024, 1024, (bf16_t*)(ws + W_O) + (size_t)2048 * 512, 512, nullptr, tile, off);
    cvt_T(p.w_out + (size_t)l * 1024 * 1024, 1024, 1024, 1024, (bf16_t*)(ws + W_OUT), 1024, nullptr, tile, off);
    cvt_T(p.w_ff1 + (size_t)l * 1024 * 4096, 1024, 4096, 4096, (bf16_t*)(ws + W_FF1), 1024, nullptr, tile, off);
    cvt_T(p.w_ff2 + (size_t)l * 4096 * 1024, 4096, 1024, 1024, (bf16_t*)(ws + W_FF2), 4096, nullptr, tile, off);
}

DI void phase_pre(const float* xin, const float* g, const float* modl, bf16_t* hdn, float* ssq) {
    const int tid = tid_opaque(), lane = tid & 63, w = tid >> 6;
    for (int row = blockIdx.x * 16 + w * 2; row < T; row += gridDim.x * 16) {
        f32x4 v[2][4];
#pragma unroll
        for (int rr = 0; rr < 2; ++rr) { const f32x4* xr = (const f32x4*)(xin + (size_t)(row + rr) * 1024) + lane;
#pragma unroll
            for (int j = 0; j < 4; ++j) v[rr][j] = xr[64 * j]; }
#pragma unroll
        for (int rr = 0; rr < 2; ++rr) { float s = 0.f;
#pragma unroll
            for (int j = 0; j < 4; ++j) s += (v[rr][j][0] * v[rr][j][0] + v[rr][j][1] * v[rr][j][1]) + (v[rr][j][2] * v[rr][j][2] + v[rr][j][3] * v[rr][j][3]);
            s = wave_sum(s); if (lane < 16) ssq[(size_t)(row + rr) * 16 + lane] = lane == 0 ? s : 0.f;
            const float* mb = modl + ((row + rr) >> 12) * 6144 + 1024;
#pragma unroll
            for (int j = 0; j < 4; ++j) { const int col = 4 * (lane + 64 * j);
                const f32x4 gg = *(const f32x4*)(g + col), sc = *(const f32x4*)(mb + col);
                *(u32x2*)(hdn + (size_t)(row + rr) * 1024 + col) = pk4(v[rr][j] * gg * (sc + 1.f)); } }
    }
}
DI void phase_final(float* xo, const bf16_t* xb, const float* g, const float* ssq) {
    const int tid = tid_opaque();
    for (int i = blockIdx.x * NTHREADS + tid; i < T * 128; i += gridDim.x * NTHREADS) {
        const int row = i >> 7, col = (i & 127) * 8; const float rstd = 1.f / sqrtf(sum16(ssq + (size_t)row * 16) * (1.f / 1024.f) + EPS);
        const u32x4 u = *(const u32x4*)(xb + (size_t)row * 1024 + col); const f32x4 g0 = *(const f32x4*)(g + col), g1 = *(const f32x4*)(g + col + 4);
        f32x4 a = {bf_lo(u.x), bf_hi(u.x), bf_lo(u.y), bf_hi(u.y)}, b = {bf_lo(u.z), bf_hi(u.z), bf_lo(u.w), bf_hi(u.w)};
        *(f32x4*)(xo + (size_t)row * 1024 + col) = (a * rstd) * g0; *(f32x4*)(xo + (size_t)row * 1024 + col + 4) = (b * rstd) * g1;
    }
}

DI void phase0(const Params& p, LAS unsigned char* lds) {
    const int tid = tid_opaque(), lane = tid & 63, w = tid >> 6; unsigned char* ws = p.ws;
    if (blockIdx.x == 0 && tid < 64) ((unsigned*)(ws + WS_CTR))[tid] = 0u;
    LAS float* cs = (LAS float*)lds;
    LAS float* red = (LAS float*)(lds + 32768);
    bool staged = false;
    for (int it = blockIdx.x; it < 192; it += gridDim.x) {
        if (!staged) { for (int i = tid; i < 8192; i += NTHREADS) { const float cv = p.c[i]; cs[i] = cv / (1.f + __expf(-cv)); } staged = true; }
        __syncthreads();
        const int l = it / 96, n = (it % 96) * 64 + lane;
        const float* wa = p.w_ada + (size_t)l * 1024 * 6144 + n;
        float a[8];
#pragma unroll
        for (int b = 0; b < 8; ++b) a[b] = 0.f;
#pragma unroll 16
        for (int k = w * 128; k < w * 128 + 128; ++k) { const float wv = wa[(size_t)k * 6144];
#pragma unroll
            for (int b = 0; b < 8; ++b) a[b] += cs[b * 1024 + k] * wv; }
#pragma unroll
        for (int b = 0; b < 8; ++b) red[(w * 8 + b) * 64 + lane] = a[b];
        __syncthreads();
        { const int b = w; float s = p.b_ada[l * 6144 + n];
#pragma unroll
          for (int ww = 0; ww < 8; ++ww) s += red[(ww * 8 + b) * 64 + lane];
          ((float*)(ws + WS_MOD))[(size_t)(l * 8 + b) * 6144 + n] = s; }
        __syncthreads();
    }
    const float L2T = 18.931568569324174f;
    float* rm = (float*)(ws + WS_ROPEM); float* rb = (float*)(ws + WS_ROPEB);
    for (int i = blockIdx.x * NTHREADS + tid; i < T * 24; i += gridDim.x * NTHREADS) {
        const int tok = i / 24, j = i % 24; const float ps = (float)p.pos[tok];
        float inv; if (j < 16) inv = exp2f(-(float)j * (L2T / 16.f)); else inv = exp2f(-(float)(j - 16) * (L2T / 8.f));
        const float ang = ps * inv; const double rev = (double)ang * 0.15915494309189535; const float fr = (float)(rev - rint(rev));
        const float sn = __builtin_amdgcn_sinf(fr), cn = __builtin_amdgcn_cosf(fr);
        if (j < 16) { rm[(size_t)tok * 32 + j] = cn; rm[(size_t)tok * 32 + 16 + j] = sn; } else { rb[(size_t)tok * 16 + (j - 16)] = cn; rb[(size_t)tok * 16 + 8 + (j - 16)] = sn; }
    }
}

DI void phase_kmean(unsigned char* ws, LAS unsigned char* lds) {
    const int tid = tid_opaque(); LAS float* red = (LAS float*)lds;
    const bf16_t* mb = (const bf16_t*)(ws + WS_MB); float* km = (float*)(ws + WS_KMEAN);
    for (int it = blockIdx.x; it < 1024; it += gridDim.x) {
        const int b = it >> 7, h = (it >> 4) & 7, nb = it & 15, c8 = tid & 7, j0 = tid >> 3;
        float s[8];
#pragma unroll
        for (int e = 0; e < 8; ++e) s[e] = 0.f;
#pragma unroll
        for (int jj = 0; jj < 4; ++jj) { const size_t row = (size_t)b * SEQ + nb * 256 + j0 + 64 * jj; const u32x4 u = *(const u32x4*)(mb + row * 1536 + 512 + h * 64 + c8 * 8);
#pragma unroll
            for (int e = 0; e < 4; ++e) { s[2 * e] += bf_lo(u[e]); s[2 * e + 1] += bf_hi(u[e]); } }
#pragma unroll
        for (int e = 0; e < 8; ++e) red[j0 * 65 + c8 * 8 + e] = s[e];
        __syncthreads();
        if (tid < 64) { float t = 0.f; for (int j = 0; j < 64; ++j) t += red[j * 65 + tid]; km[(size_t)it * 64 + tid] = t * (1.f / 256.f); }
        __syncthreads();
    }
}

#define XB_TMO      128
#define XB_XCNT(j)  (256  + 64 * (j))
#define XB_XSUB(j)  (1280 + 64 * (j))
#define XB_XGEN(j)  (2304 + 64 * (j))
#define XB_TOP      3328
#define XB_TOPGEN   3392
#define XCD_BAR_WORDS 3456
#define XB_SPIN_CAP (1u << 22)
DI unsigned xb_ld(unsigned* p)              { return __hip_atomic_load(p, __ATOMIC_RELAXED, __HIP_MEMORY_SCOPE_AGENT); }
DI unsigned xb_add(unsigned* p, unsigned v) { return __hip_atomic_fetch_add(p, v, __ATOMIC_RELAXED, __HIP_MEMORY_SCOPE_AGENT); }
DI unsigned xb_xcc_id() { return (unsigned)__builtin_amdgcn_s_getreg((3 << 11) | 20) & 0xFu; }
#define XB_SPIN(cond, bar) do { unsigned _sp = 0; while (cond) { __builtin_amdgcn_s_sleep(1); \
    if ((++_sp & 255u) == 0u) { if (xb_ld(&(bar)[XB_TMO])) break; if (_sp > XB_SPIN_CAP) { atomicAdd(&(bar)[XB_TMO], 1u); break; } } } } while (0)
struct XcdBarrier { unsigned* bar; unsigned x; volatile LAS unsigned* st; };
DI XcdBarrier xcd_barrier_post(unsigned* bar, volatile LAS unsigned* st) {
    XcdBarrier b; b.bar = bar; b.x = xb_xcc_id(); b.st = st;
    if (threadIdx.x == 0) (void)xb_add(&bar[XB_XCNT(b.x)], 1u);
    return b;
}
DI void xcd_barrier_complete(unsigned* bar, unsigned x, unsigned& nloc, unsigned& nx) {
    const unsigned G = gridDim.x * gridDim.y * gridDim.z;
    unsigned sum, cnt, mine, sp = 0u;
    for (;;) {
        sum = 0u; cnt = 0u; mine = 0u;
#pragma unroll
        for (unsigned j = 0; j < 16; ++j) { const unsigned c = xb_ld(&bar[XB_XCNT(j)]); sum += c; cnt += (c > 0u) ? 1u : 0u; mine = (j == x) ? c : mine; }
        if (sum == G) break;
        __builtin_amdgcn_s_sleep(1);
        if ((++sp & 255u) == 0u) { if (xb_ld(&bar[XB_TMO])) break; if (sp > XB_SPIN_CAP) { atomicAdd(&bar[XB_TMO], 1u); break; } }
    }
    nloc = mine > 0u ? mine : 1u; nx = cnt > 0u ? cnt : 1u;
}
DI void xcd_barrier(const XcdBarrier& b) {
    asm volatile("s_waitcnt vmcnt(0)" ::: "memory");
    __syncthreads();
    if (threadIdx.x == 0) {
        unsigned* bar = b.bar;
        __builtin_amdgcn_s_waitcnt(0);
        unsigned nloc = b.st[0], nx = b.st[1];
        if (nloc == 0u) { xcd_barrier_complete(bar, b.x, nloc, nx); b.st[0] = nloc; b.st[1] = nx; }
        const unsigned old = xb_add(&bar[XB_XSUB(b.x)], 1u);
        const unsigned gen = old / nloc;
        if (old + 1u == (gen + 1u) * nloc) {
            __builtin_amdgcn_fence(__ATOMIC_RELEASE, "agent");
            asm volatile("s_waitcnt vmcnt(0)" ::: "memory");
            const unsigned og = xb_add(&bar[XB_TOP], 1u);
            const unsigned tg = og / nx;
            if (og + 1u == (tg + 1u) * nx) xb_add(&bar[XB_TOPGEN], 1u);
            else XB_SPIN(xb_ld(&bar[XB_TOPGEN]) == tg, bar);
            __builtin_amdgcn_fence(__ATOMIC_ACQUIRE, "agent");
            xb_add(&bar[XB_XGEN(b.x)], 1u);
            asm volatile("s_waitcnt vmcnt(0)" ::: "memory");
        } else {
            XB_SPIN(xb_ld(&bar[XB_XGEN(b.x)]) == gen, bar);
            __builtin_amdgcn_fence(__ATOMIC_ACQUIRE, "agent");
            asm volatile("s_waitcnt vmcnt(0)" ::: "memory");
        }
    }
    __syncthreads();
}
constexpr size_t WS_BAR = 4096;
constexpr int NPHASE = 18;
__global__ void __launch_bounds__(NTHREADS, 2) fwd_kernel(Params p_unused) {
#if defined(__HIP_DEVICE_COMPILE__)
    extern __shared__ __attribute__((aligned(16))) unsigned char lds_raw[];
    LAS unsigned char* lds = (LAS unsigned char*)lds_raw;
    cg::grid_group grid = cg::this_grid();
    PP pk = (PP)__builtin_amdgcn_kernarg_segment_ptr();
    const int ph_lo = pk->ph_lo, ph_hi = pk->ph_hi;
    volatile LAS unsigned* xst = (volatile LAS unsigned*)(lds + 131072 + 4096);
    if (threadIdx.x == 0) { xst[0] = 0u; xst[1] = 0u; }
    __syncthreads();
    const XcdBarrier xbar = xcd_barrier_post((unsigned*)(pk->ws + WS_BAR), xst);
    for (int ph = ph_lo; ph < ph_hi; ++ph) {
        if (ph > ph_lo) { if (ph == ph_lo + 1) grid.sync(); else xcd_barrier(xbar); }
        PP pp = pk; asm volatile("" : "+s"(pp));
        if (ph == 0) { const Params p = *pp; phase0(p, lds); continue; }
        if (ph == NPHASE - 1) { phase_final(pp->out, (const bf16_t*)(pp->ws + WS_HDN), pp->final_g, (const float*)(pp->ws + WS_SSQXP) + (size_t)2 * T * 16); continue; }
        const int l = (ph - 1) >> 3, s = (ph - 1) & 7;
        if (s == 0) {
            const Params p = *pp; unsigned char* ws = p.ws;
            phase_convert(p, l, lds);
            __syncthreads();
            phase_bias(p, l, lds);
            if (l == 0) phase_pre(p.x, p.norm1_g, (const float*)(ws + WS_MOD), (bf16_t*)(ws + WS_HDN), (float*)(ws + WS_SSQXP));
        } else if (s == 3) {
            unsigned char* ws = pp->ws;
            attn_phase(ws, lds, (unsigned*)(ws + WS_CTR) + l, ph_hi == 12345);
        } else {
            unsigned char* ws = pp->ws;
            pg8::Sched S; S.G = gridDim.x; S.c = blockIdx.x; S.ws = (const char*)ws;
            pg8::Epi E; E.pp = pk; E.l = l;
            S.mode = s == 1 ? pg8::M_PROJ : (s == 2 ? pg8::M_UP : (s == 4 ? pg8::M_MERGE : (s == 5 ? pg8::M_OUT : (s == 6 ? pg8::M_FF1 : pg8::M_FF2))));
            pg8::gemm_phase(lds, S, E);
            if (s == 2) phase_kmean(ws, lds);
        }
    }
#endif
}

extern "C" void kernel_launch(void* const* d_in, const int* in_sizes, int n_in, void* d_out, int out_size, void* d_ws, size_t ws_size, hipStream_t stream) {
    static int grid = 0;
    if (grid == 0) {
        if (n_in != 19 || in_sizes[0] != T * DM || out_size != T * DM || ws_size < WS_END) {
            fprintf(stderr, "kernel_launch: unexpected shapes/workspace (n_in %d, in0 %d, out %d, ws %zu; need ws >= %zu); nothing launched\n", n_in, n_in > 0 ? in_sizes[0] : -1, out_size, ws_size, (size_t)WS_END);
            grid = -1; return; }
        int dev = 0, cus = 0, per_cu = 0;
        hipGetDevice(&dev); hipDeviceGetAttribute(&cus, hipDeviceAttributeMultiprocessorCount, dev);
        if (hipFuncSetAttribute((const void*)fwd_kernel, hipFuncAttributeMaxDynamicSharedMemorySize, LDS_BYTES) != hipSuccess) { fprintf(stderr, "kernel_launch: hipFuncSetAttribute failed\n"); grid = -1; return; }
        if (hipOccupancyMaxActiveBlocksPerMultiprocessor(&per_cu, (const void*)fwd_kernel, NTHREADS, LDS_BYTES) != hipSuccess || per_cu < 1) { fprintf(stderr, "kernel_launch: occupancy query says %d blocks/CU\n", per_cu); per_cu = 1; }
        (void)hipGetLastError();
        grid = cus * per_cu; if (grid > 256) grid = 256; if (grid % 8) grid -= grid % 8;
    }
    if (grid <= 0) return;
    Params p{};
    p.x = (const float*)d_in[0]; p.c = (const float*)d_in[1]; p.pos = (const int*)d_in[2]; p.w_ada = (const float*)d_in[3]; p.b_ada = (const float*)d_in[4];
    p.norm1_g = (const float*)d_in[5]; p.norm2_g = (const float*)d_in[6]; p.w_in = (const float*)d_in[7]; p.q_norm_g = (const float*)d_in[8]; p.w_uq = (const float*)d_in[9];
    p.kv_norm_g = (const float*)d_in[10]; p.w_ukv = (const float*)d_in[11]; p.w_o_mla = (const float*)d_in[12]; p.w_o_sb = (const float*)d_in[13]; p.w_o_moba = (const float*)d_in[14];
    p.w_out = (const float*)d_in[15]; p.w_ff1 = (const float*)d_in[16]; p.w_ff2 = (const float*)d_in[17]; p.final_g = (const float*)d_in[18];
    p.out = (float*)d_out; p.ws = (unsigned char*)d_ws; p.ph_lo = 0; p.ph_hi = NPHASE;
    (void)hipMemsetAsync((char*)d_ws + WS_BAR, 0, 16384, stream);
    void* args[] = {&p};
    hipError_t e = hipLaunchCooperativeKernel((const void*)fwd_kernel, dim3(grid), dim3(NTHREADS), args, LDS_BYTES, stream);
    if (e != hipSuccess) fprintf(stderr, "kernel_launch: cooperative launch failed: %s (grid %d)\n", hipGetErrorString(e), grid);
}
```
